# Optimizing an MI355X kernel written in HIP

```python
import jax, jax.numpy as jnp
from jax import lax
import numpy as np

D_MODEL = 1024
BATCH = 32
SEQ = 256
DEPTH = 2
DEC_BATCH = 2
DEC_SEQ = 2048
PAST_LEN = 512

GRID_W = 64
HEAD_DIM = 64
NA_HEADS = 8
NA_WIN_R = 8
NA_WIN_C = 16
NA_QC = 16
NA_KC = NA_QC + NA_WIN_C
GQA_HEADS = 8
GQA_KV_HEADS = 2
QKV_WIDTH = 3 * NA_HEADS * HEAD_DIM + (GQA_HEADS + 2 * GQA_KV_HEADS) * HEAD_DIM
ATTN_OUT_WIDTH = (NA_HEADS + GQA_HEADS) * HEAD_DIM
ROPE_BASE = 10000.0
Q_BLOCK = 128
SGU_CHUNK = 128
SGU_GROUPS = 8
SGU_WIDTH = 2 * D_MODEL
FFN_HIDDEN = 2816
N_MOD = 9
N_ATTN_LAYERS = (DEPTH + 1) // 2
N_SGU_LAYERS = DEPTH // 2
EPS = 1e-6
NEG_INF = -1e30

kernel_name = 'hybrid_na_gqa_gmlp_diffusion_step'


def rms_norm(x, g):
    xf = x.astype(jnp.float32)
    y = xf * lax.rsqrt(jnp.mean(xf * xf, axis=-1, keepdims=True) + EPS)
    return (y * g.astype(jnp.float32)).astype(x.dtype)


def modulation(cond, w, b):
    m = jax.nn.silu(cond) @ w + b
    return m.reshape(cond.shape[0], 1, N_MOD, D_MODEL)


def adaln_input(h, mod, j, g):
    return rms_norm(h, g) * (1 + mod[:, :, 3 * j + 1]) + mod[:, :, 3 * j]


def adaln_gate(mod, j):
    return mod[:, :, 3 * j + 2]


def swiglu(x, w_gu, w_down):
    gate, up = jnp.split(x @ w_gu, 2, axis=-1)
    return (jax.nn.silu(gate) * up) @ w_down


def axial_rope(x):
    T, D = x.shape[1], x.shape[3]
    t = jnp.arange(T)
    half = D // 2
    freqs = ROPE_BASE ** (-jnp.arange(0, half, 2, dtype=jnp.float32) / half)

    def rotate(xa, pos):
        ang = pos.astype(jnp.float32)[:, None] * freqs[None, :]
        cos = jnp.cos(ang)[None, :, None, :]
        sin = jnp.sin(ang)[None, :, None, :]
        x1, x2 = jnp.split(xa.astype(jnp.float32), 2, axis=-1)
        return jnp.concatenate([x1 * cos - x2 * sin, x1 * sin + x2 * cos], axis=-1)

    out = jnp.concatenate([rotate(x[..., :half], t // GRID_W), rotate(x[..., half:], t % GRID_W)], axis=-1)
    return out.astype(x.dtype)


def attn_project(xn, w_in, na_q_g, na_k_g, gqa_q_g, gqa_k_g):
    B, S, _ = xn.shape
    na_w = NA_HEADS * HEAD_DIM
    q_w = GQA_HEADS * HEAD_DIM
    kv_w = GQA_KV_HEADS * HEAD_DIM
    splits = [na_w, 2 * na_w, 3 * na_w, 3 * na_w + q_w, 3 * na_w + q_w + kv_w]
    qa, ka, va, qb, kb, vb = jnp.split(xn @ w_in, splits, axis=-1)
    heads = lambda t: t.reshape(B, S, -1, HEAD_DIM)
    return (rms_norm(heads(qa), na_q_g), rms_norm(heads(ka), na_k_g), heads(va),
            rms_norm(heads(qb), gqa_q_g), rms_norm(heads(kb), gqa_k_g), heads(vb))


def dense_attention(q, k, v):
    B, S, Hq, D = q.shape
    Hk = k.shape[2]
    G = Hq // Hk
    nb = S // Q_BLOCK
    qb = (q * D ** -0.5).reshape(B, nb, Q_BLOCK, Hk, G, D).transpose(1, 0, 2, 3, 4, 5)

    def block(qblk):
        s = jnp.einsum('bqkgd,bskd->bkgqs', qblk, k).astype(jnp.float32)
        p = jax.nn.softmax(s, axis=-1).astype(v.dtype)
        return jnp.einsum('bkgqs,bskd->bqkgd', p, v)

    o = lax.map(block, qb)
    return o.transpose(1, 0, 2, 3, 4, 5).reshape(B, S, Hq, D)


def neighbourhood_attention(q, k, v, ctx_k, ctx_v, rpb):
    B, T, H, D = q.shape
    rows = T // GRID_W
    wr = min(NA_WIN_R, rows)
    ncb = GRID_W // NA_QC
    r = jnp.arange(rows)
    row_idx = jnp.clip(r - wr // 2, 0, rows - wr)[:, None] + jnp.arange(wr)[None, :]
    cb = jnp.arange(ncb)
    col_idx = jnp.clip(cb * NA_QC - NA_WIN_C // 2, 0, GRID_W - NA_KC)[:, None] + jnp.arange(NA_KC)[None, :]
    q_col = cb[:, None] * NA_QC + jnp.arange(NA_QC)[None, :]
    win_start = jnp.clip(q_col - NA_WIN_C // 2, 0, GRID_W - NA_WIN_C)
    kc = col_idx[:, None, :]
    ws = win_start[:, :, None]
    col_ok = (kc >= ws) & (kc < ws + NA_WIN_C)
    dr = row_idx - r[:, None] + NA_WIN_R - 1
    dc = jnp.clip(kc - q_col[:, :, None] + NA_WIN_C - 1, 0, 2 * NA_WIN_C - 2)
    bias = rpb[:, dr[:, None, None, :, None], dc[None, :, :, None, :]]
    bias = jnp.where(col_ok[None, None, :, :, None, :], bias.astype(jnp.float32), NEG_INF)
    n_loc = wr * NA_KC
    bias = bias.reshape(H, rows, ncb, NA_QC, n_loc).transpose(1, 2, 0, 3, 4)

    qg = (q * D ** -0.5).reshape(B, rows, ncb, NA_QC, H, D)
    kg = k.reshape(B, rows, GRID_W, H, D)
    vg = v.reshape(B, rows, GRID_W, H, D)
    ri = row_idx[:, None, :, None]
    ci = col_idx[None, :, None, :]
    kb = kg[:, ri, ci].reshape(B, rows, ncb, n_loc, H, D)
    vb = vg[:, ri, ci].reshape(B, rows, ncb, n_loc, H, D)
    s_loc = jnp.einsum('brnqhd,brnkhd->brnhqk', qg, kb).astype(jnp.float32) + bias[None]
    s_ctx = jnp.einsum('brnqhd,blhd->brnhql', qg, ctx_k).astype(jnp.float32)
    p = jax.nn.softmax(jnp.concatenate([s_loc, s_ctx], axis=-1), axis=-1).astype(v.dtype)
    o = (jnp.einsum('brnhqk,brnkhd->brnqhd', p[..., :n_loc], vb)
         + jnp.einsum('brnhql,blhd->brnqhd', p[..., n_loc:], ctx_v))
    return o.reshape(B, T, H, D)


def merge_heads(oa, ob, w_out):
    B, S = oa.shape[0], oa.shape[1]
    return jnp.concatenate([oa.reshape(B, S, -1), ob.reshape(B, S, -1)], axis=-1) @ w_out


def sgu_mixer(xn, w_in, v_g, w_s, b_s, w_out):
    B, S, _ = xn.shape
    u, v = jnp.split(jax.nn.gelu(xn @ w_in, approximate=False), 2, axis=-1)
    v = rms_norm(v, v_g)
    nc = S // SGU_CHUNK
    gw = SGU_WIDTH // SGU_GROUPS
    vg = v.reshape(B, nc, SGU_CHUNK, SGU_GROUPS, gw)
    sv = jnp.einsum('gts,bcsgd->bctgd', w_s, vg) + b_s.T[None, None, :, :, None]
    gated = u.reshape(B, nc, SGU_CHUNK, SGU_GROUPS, gw) * sv
    return gated.reshape(B, S, SGU_WIDTH) @ w_out


def setup_inputs(seed: int = 0) -> dict:
    key = jax.random.key(seed)
    ks = jax.random.split(key, 27)
    nrm = lambda k, shape, scale: jax.random.normal(k, shape, jnp.float32) * scale
    D = D_MODEL
    return {
        'x_prompt': nrm(ks[0], (BATCH, SEQ, D), 1.0),
        'x_sample': nrm(ks[1], (DEC_BATCH, DEC_SEQ, D), 1.0),
        'cache_na_k': nrm(ks[2], (DEC_BATCH, N_ATTN_LAYERS, PAST_LEN, NA_HEADS, HEAD_DIM), 1.0),
        'cache_na_v': nrm(ks[3], (DEC_BATCH, N_ATTN_LAYERS, PAST_LEN, NA_HEADS, HEAD_DIM), 1.0),
        'cache_gqa_k': nrm(ks[4], (DEC_BATCH, N_ATTN_LAYERS, PAST_LEN, GQA_KV_HEADS, HEAD_DIM), 1.0),
        'cache_gqa_v': nrm(ks[5], (DEC_BATCH, N_ATTN_LAYERS, PAST_LEN, GQA_KV_HEADS, HEAD_DIM), 1.0),
        'c': nrm(ks[6], (DEC_BATCH, D), 1.0),
        'c_ctx': nrm(ks[7], (D,), 1.0),
        'norm_g': 1.0 + nrm(ks[8], (DEPTH, 3, D), 0.1),
        'mod_w': nrm(ks[9], (DEPTH, D, N_MOD * D), 0.5 * D ** -0.5),
        'mod_b': nrm(ks[10], (DEPTH, N_MOD * D), 0.01),
        'ffn1_w_gu': nrm(ks[11], (DEPTH, D, 2 * FFN_HIDDEN), D ** -0.5),
        'ffn1_w_down': nrm(ks[12], (DEPTH, FFN_HIDDEN, D), FFN_HIDDEN ** -0.5),
        'ffn2_w_gu': nrm(ks[13], (DEPTH, D, 2 * FFN_HIDDEN), D ** -0.5),
        'ffn2_w_down': nrm(ks[14], (DEPTH, FFN_HIDDEN, D), FFN_HIDDEN ** -0.5),
        'attn_w_in': nrm(ks[15], (N_ATTN_LAYERS, D, QKV_WIDTH), D ** -0.5),
        'attn_w_out': nrm(ks[16], (N_ATTN_LAYERS, ATTN_OUT_WIDTH, D), ATTN_OUT_WIDTH ** -0.5),
        'na_q_g': 1.0 + nrm(ks[17], (N_ATTN_LAYERS, HEAD_DIM), 0.1),
        'na_k_g': 1.0 + nrm(ks[18], (N_ATTN_LAYERS, HEAD_DIM), 0.1),
        'na_rpb': nrm(ks[19], (N_ATTN_LAYERS, NA_HEADS, 2 * NA_WIN_R - 1, 2 * NA_WIN_C - 1), 0.1),
        'gqa_q_g': 1.0 + nrm(ks[20], (N_ATTN_LAYERS, HEAD_DIM), 0.1),
        'gqa_k_g': 1.0 + nrm(ks[21], (N_ATTN_LAYERS, HEAD_DIM), 0.1),
        'sgu_w_in': nrm(ks[22], (N_SGU_LAYERS, D, 2 * SGU_WIDTH), D ** -0.5),
        'sgu_v_g': 1.0 + nrm(ks[23], (N_SGU_LAYERS, SGU_WIDTH), 0.1),
        'sgu_w_s': nrm(ks[24], (N_SGU_LAYERS, SGU_GROUPS, SGU_CHUNK, SGU_CHUNK), 0.5 * SGU_CHUNK ** -0.5),
        'sgu_b_s': 1.0 + nrm(ks[25], (N_SGU_LAYERS, SGU_GROUPS, SGU_CHUNK), 0.1),
        'sgu_w_out': nrm(ks[26], (N_SGU_LAYERS, SGU_WIDTH, D), SGU_WIDTH ** -0.5),
    }


def reference(x_prompt, x_sample, cache_na_k, cache_na_v, cache_gqa_k, cache_gqa_v, c, c_ctx,
              norm_g, mod_w, mod_b, ffn1_w_gu, ffn1_w_down, ffn2_w_gu, ffn2_w_down,
              attn_w_in, attn_w_out, na_q_g, na_k_g, na_rpb, gqa_q_g, gqa_k_g,
              sgu_w_in, sgu_v_g, sgu_w_s, sgu_b_s, sgu_w_out):
    hp = x_prompt
    hs = x_sample
    na_k_list, na_v_list, gqa_k_list, gqa_v_list = [], [], [], []
    for i in range(DEPTH):
        m_ctx = modulation(c_ctx[None, :], mod_w[i], mod_b[i])
        m_lat = modulation(c, mod_w[i], mod_b[i])

        hp = hp + 0.5 * adaln_gate(m_ctx, 0) * swiglu(adaln_input(hp, m_ctx, 0, norm_g[i, 0]), ffn1_w_gu[i], ffn1_w_down[i])
        hs = hs + 0.5 * adaln_gate(m_lat, 0) * swiglu(adaln_input(hs, m_lat, 0, norm_g[i, 0]), ffn1_w_gu[i], ffn1_w_down[i])

        xp = adaln_input(hp, m_ctx, 1, norm_g[i, 1])
        xs = adaln_input(hs, m_lat, 1, norm_g[i, 1])
        if i % 2 == 0:
            e = i // 2
            qa, ka, va, qb, kb, vb = attn_project(xp, attn_w_in[e], na_q_g[e], na_k_g[e], gqa_q_g[e], gqa_k_g[e])
            out_p = merge_heads(dense_attention(qa, ka, va), dense_attention(qb, kb, vb), attn_w_out[e])
            na_k_list.append(ka)
            na_v_list.append(va)
            gqa_k_list.append(kb)
            gqa_v_list.append(vb)
            qa, ka, va, qb, kb, vb = attn_project(xs, attn_w_in[e], na_q_g[e], na_k_g[e], gqa_q_g[e], gqa_k_g[e])
            oa = neighbourhood_attention(qa, ka, va, cache_na_k[:, e], cache_na_v[:, e], na_rpb[e])
            ob = dense_attention(axial_rope(qb),
                                 jnp.concatenate([axial_rope(kb), cache_gqa_k[:, e]], axis=1),
                                 jnp.concatenate([vb, cache_gqa_v[:, e]], axis=1))
            out_s = merge_heads(oa, ob, attn_w_out[e])
        else:
            o = i // 2
            out_p = sgu_mixer(xp, sgu_w_in[o], sgu_v_g[o], sgu_w_s[o], sgu_b_s[o], sgu_w_out[o])
            out_s = sgu_mixer(xs, sgu_w_in[o], sgu_v_g[o], sgu_w_s[o], sgu_b_s[o], sgu_w_out[o])
        hp = hp + adaln_gate(m_ctx, 1) * out_p
        hs = hs + adaln_gate(m_lat, 1) * out_s

        hp = hp + 0.5 * adaln_gate(m_ctx, 2) * swiglu(adaln_input(hp, m_ctx, 2, norm_g[i, 2]), ffn2_w_gu[i], ffn2_w_down[i])
        hs = hs + 0.5 * adaln_gate(m_lat, 2) * swiglu(adaln_input(hs, m_lat, 2, norm_g[i, 2]), ffn2_w_gu[i], ffn2_w_down[i])

    new_na_k = jnp.stack(na_k_list, axis=1)
    new_na_v = jnp.stack(na_v_list, axis=1)
    new_gqa_k = jnp.stack(gqa_k_list, axis=1)
    new_gqa_v = jnp.stack(gqa_v_list, axis=1)
    return (hp, hs, new_na_k, new_na_v, new_gqa_k, new_gqa_v)
```

```cpp
#include <hip/hip_runtime.h>
#include <hip/hip_cooperative_groups.h>
#include <cstdio>
#include <cstdint>
namespace cg = cooperative_groups;

#define LAS __attribute__((address_space(3)))
#define DI __device__ __forceinline__
typedef unsigned short bf16_t;
typedef short bf16x8 __attribute__((ext_vector_type(8)));
typedef float f32x4 __attribute__((ext_vector_type(4)));
typedef float f32x2 __attribute__((ext_vector_type(2)));
typedef float f32x16 __attribute__((ext_vector_type(16)));
typedef unsigned u32x4 __attribute__((ext_vector_type(4)));
typedef unsigned u32x2 __attribute__((ext_vector_type(2)));
typedef __bf16 bf16x2_t __attribute__((ext_vector_type(2)));

constexpr int D = 1024, MTOK = 12288, MP = 8192, FH = 2816, NMOD = 9216;
constexpr float LOG2E = 1.4426950408889634f;
constexpr float EPS = 1e-6f;
constexpr size_t O_NAK = 12582912, O_NAV = 16777216, O_GK = 20971520, O_GV = 22020096;
constexpr size_t MiB = 1u << 20;
constexpr size_t WS_CTL = 0, CTL_BYTES = 704 * 1024;
constexpr size_t WS_RSS = 131072;
constexpr size_t WS_SW = 5 * MiB;
constexpr int SW_QKV = 4 * 3 * 5632, SW_SGU = SW_QKV + 3 * 2560;
constexpr size_t WS_GTAB = 768 * 1024;
constexpr size_t WS_MOD = 448 * 1024;
constexpr size_t WS_KCNA = 2 * MiB, WS_VCNAT = 3 * MiB, WS_KCG = 4 * MiB, WS_VCGT = 4 * MiB + 256 * 1024;
constexpr size_t WS_W = 8 * MiB, FFN_STRIDE = 17301504, FFN_DOWN = 11 * MiB;
constexpr size_t WS_WQK = 74 * MiB, WS_WV = WS_WQK + 3670016, WS_WO = 79 * MiB, WS_WSI = 81 * MiB, WS_WSO = 89 * MiB;
constexpr size_t WS_XN = 96 * MiB;
constexpr size_t WS_R = 120 * MiB;
constexpr size_t R_HID = 0;
constexpr size_t R_QNA = 0, R_KNA = 12 * MiB, R_QG = 24 * MiB, R_KG = 36 * MiB, R_VT = 40 * MiB, R_AO = 58 * MiB;
constexpr size_t R_U = 0, R_VTS = 48 * MiB;
constexpr size_t WS_END = 216 * MiB;
constexpr int LDS_BYTES = 135168;

struct Params { const float* in[27]; float* out; unsigned char* ws; int ph_lo, ph_hi, rep_ph, rep_n; };

DI unsigned pk2(float lo, float hi) { f32x2 v = {lo, hi}; bf16x2_t b = __builtin_convertvector(v, bf16x2_t); return __builtin_bit_cast(unsigned, b); }
DI float bf2f(unsigned short b) { return __builtin_bit_cast(float, (unsigned)b << 16); }
template <int CTRL> DI float dppf(float v) { return __builtin_bit_cast(float, __builtin_amdgcn_update_dpp(0, __builtin_bit_cast(int, v), CTRL, 0xf, 0xf, true)); }
DI float row16_sum(float v) { v += dppf<0xB1>(v); v += dppf<0x4E>(v); v += dppf<0x124>(v); v += dppf<0x128>(v); return v; }
DI float xor16_sum(float v) { const unsigned b = __builtin_bit_cast(unsigned, v); auto r = __builtin_amdgcn_permlane16_swap(b, b, false, false); return __builtin_bit_cast(float, (unsigned)r[0]) + __builtin_bit_cast(float, (unsigned)r[1]); }
DI float xor32_sum(float v) { const unsigned b = __builtin_bit_cast(unsigned, v); auto r = __builtin_amdgcn_permlane32_swap(b, b, false, false); return __builtin_bit_cast(float, (unsigned)r[0]) + __builtin_bit_cast(float, (unsigned)r[1]); }
DI float xor32_max(float v) { const unsigned b = __builtin_bit_cast(unsigned, v); auto r = __builtin_amdgcn_permlane32_swap(b, b, false, false); return fmaxf(__builtin_bit_cast(float, (unsigned)r[0]), __builtin_bit_cast(float, (unsigned)r[1])); }
DI float wave_sum(float v) { return xor32_sum(xor16_sum(row16_sum(v))); }
DI f32x4 quad_transpose(f32x4 v, int q) {
    const bool odd = q & 1, hi2 = q & 2;
    { const float s0 = odd ? v[0] : v[1], s1 = odd ? v[2] : v[3]; const float r0 = dppf<0xB1>(s0), r1 = dppf<0xB1>(s1);
      if (!odd) { v[1] = r0; v[3] = r1; } else { v[0] = r0; v[2] = r1; } }
    { const float s0 = hi2 ? v[0] : v[2], s1 = hi2 ? v[1] : v[3]; const float r0 = dppf<0x4E>(s0), r1 = dppf<0x4E>(s1);
      if (!hi2) { v[2] = r0; v[3] = r1; } else { v[0] = r0; v[1] = r1; } }
    return v;
}
DI float silu_f(float x) { return x * __builtin_amdgcn_rcpf(1.f + __builtin_amdgcn_exp2f(-x * LOG2E)); }
DI f32x2 gelu_pk(f32x2 v) {
    const f32x2 av = __builtin_elementwise_abs(v), d = av * 0.2316418882f + 1.0f;
    f32x2 t; t.x = __builtin_amdgcn_rcpf(d.x); t.y = __builtin_amdgcn_rcpf(d.y);
    f32x2 q = t * 0.5307027145f + (-0.7265760135f); q = q * t + 0.7107068705f; q = q * t + (-0.142248368f); q = q * t + 0.127414796f; q = q * t;
    const f32x2 s = (v * v) * (-0.72134752044f);
    f32x2 e; e.x = __builtin_amdgcn_exp2f(s.x); e.y = __builtin_amdgcn_exp2f(s.y);
    const f32x2 m = v * (q * e), r = v - m;
    f32x2 o; o.x = v.x < 0.f ? m.x : r.x; o.y = v.y < 0.f ? m.y : r.y; return o;
}
DI f32x4 gelu4(f32x4 v) { f32x2 a = gelu_pk((f32x2){v[0], v[1]}), b = gelu_pk((f32x2){v[2], v[3]}); return (f32x4){a.x, a.y, b.x, b.y}; }

namespace pg8 {
constexpr int BM = 256, BK = 64, HALF = 128, HTB = HALF * BK * 2, NXCD = 8, WGM = 8;
DI int lds_byte(int r, int c) { const int st = (r >> 4) * 2 + (c >> 5), rr = r & 15, cc = c & 31, ob = rr * 64 + cc * 2; return st * 1024 + (ob ^ (((ob >> 9) & 1) << 5)); }
DI void stage_rc(int b, int& R, int& C) { const int st = b / 1024, sb = b % 1024, swz = sb ^ (((sb >> 9) & 1) << 5); R = (st >> 1) * 16 + swz / 64; C = (st & 1) * 32 + (swz % 64) / 2; }
DI int perm32(int rho) { const int n = rho >> 4, i = rho & 15; return 8 * (i >> 2) + 4 * n + (i & 3); }

struct Unit { const char* a; const char* b; int pm, pn, kind; };
struct GemmDesc { const char* A; const char* B; int nM, nN, pmoff, pnoff; };
struct Sched2 {
    GemmDesc g0, g1; int nwg0, nwg, G, c; size_t tstep;
    DI void init(const GemmDesc& a, const GemmDesc& b, int K, int G_, int c_) { g0 = a; g1 = b; nwg0 = a.nM * a.nN; nwg = nwg0 + b.nM * b.nN; G = G_; c = c_; tstep = (size_t)BM * K * 2; }
    DI bool next(int i, Unit& u) const {
        const long L = (long)i * G + c; if (L >= nwg) return false;
        int wgid = (int)L;
        if ((G & 7) == 0) { const int q = nwg / NXCD, r = nwg % NXCD, xcd = wgid % NXCD, off = wgid / NXCD; wgid = (xcd < r ? xcd * (q + 1) : r * (q + 1) + (xcd - r) * q) + off; }
        const bool k1 = wgid >= nwg0; if (k1) wgid -= nwg0;
        const int nM = k1 ? g1.nM : g0.nM, nN = k1 ? g1.nN : g0.nN;
        const int nig = WGM * nN, gid = wgid / nig, fm = gid * WGM, gsz = (nM - fm) < WGM ? (nM - fm) : WGM;
        const int lpm = fm + ((wgid % nig) % gsz), lpn = (wgid % nig) / gsz; u.kind = k1 ? 1 : 0;
        u.a = (k1 ? g1.A : g0.A) + (size_t)lpm * tstep; u.b = (k1 ? g1.B : g0.B) + (size_t)lpn * tstep;
        u.pm = lpm + (k1 ? g1.pmoff : g0.pmoff); u.pn = lpn + (k1 ? g1.pnoff : g0.pnoff);
        return true;
    }
};

template <class Epi, class Sched>
DI void gemm_phase(LAS unsigned char* lds, const int tid, const int K, const Sched& S, const Epi& E) {
    const int wid = __builtin_amdgcn_readfirstlane(tid >> 6), lane = tid & 63, wr = wid >> 2, wc = wid & 3, fr = lane & 15, fq = lane >> 4;
    const int nt = K / BK;
    unsigned voffA[2], voffB[2];
#pragma unroll
    for (int i = 0; i < 2; ++i) { int R, C; stage_rc(tid * 16 + i * 8192, R, C); const int Rb = Epi::PERM ? ((R & ~31) + perm32(R & 31)) : R;
        voffA[i] = (unsigned)(R * K + C) * 2u; voffB[i] = (unsigned)(Rb * K + C) * 2u; }
    const size_t kstep = (size_t)(BK * 2);
    const size_t hstep = (size_t)HALF * K * 2;
    const unsigned ldsw = (unsigned)wid * 1024u;
    const int aoff = lds_byte(wr * 64 + fr, fq * 8), boff = lds_byte(wc * 32 + fr, fq * 8);
#define PG8_SA(b, h) (((b) * 2 + (h)) * HTB)
#define PG8_SB(b, h) ((4 + (b) * 2 + (h)) * HTB)
#define PG8_STAGE(bufoff, gbase, voff) do { _Pragma("unroll") for (int _i = 0; _i < 2; ++_i) \
        __builtin_amdgcn_global_load_lds((const unsigned*)((const char*)(gbase) + (voff)[_i]), (LAS unsigned*)(lds + (bufoff) + ldsw + _i * 8192), 16, 0, 0); } while (0)
#define PG8_LDA(dst, b, h) do { _Pragma("unroll") for (int m = 0; m < 4; ++m) _Pragma("unroll") for (int k = 0; k < 2; ++k) dst[m][k] = *(const LAS bf16x8*)(lds + PG8_SA(b, h) + aoff + m * 2048 + k * 1024); } while (0)
#define PG8_LDB(dst, b, h) do { _Pragma("unroll") for (int n = 0; n < 2; ++n) _Pragma("unroll") for (int k = 0; k < 2; ++k) dst[n][k] = *(const LAS bf16x8*)(lds + PG8_SB(b, h) + boff + n * 2048 + k * 1024); } while (0)
#define PG8_MMA(ai, bj, At, Bt) do { __builtin_amdgcn_s_setprio(1); _Pragma("unroll") for (int m = 0; m < 4; ++m) _Pragma("unroll") for (int n = 0; n < 2; ++n) _Pragma("unroll") for (int k = 0; k < 2; ++k) \
        acc[ai][bj][m][n] = __builtin_amdgcn_mfma_f32_16x16x32_bf16(Bt[n][k], At[m][k], acc[ai][bj][m][n], 0, 0, 0); __builtin_amdgcn_s_setprio(0); } while (0)
#define PG8_WAIT_V(n) asm volatile("s_waitcnt vmcnt(" #n ")" ::: "memory")
#define PG8_WAIT_L(n) asm volatile("s_waitcnt lgkmcnt(" #n ")" ::: "memory")
#define PG8_BAR __builtin_amdgcn_s_barrier()
#define PG8_SCHED __builtin_amdgcn_sched_barrier(0)
    Unit cur, nxt; int ui = 0;
    if (!S.next(0, cur)) return;
    f32x4 acc[2][2][4][2];
#pragma unroll
    for (int a = 0; a < 2; ++a)
#pragma unroll
        for (int b = 0; b < 2; ++b)
#pragma unroll
            for (int m = 0; m < 4; ++m)
#pragma unroll
                for (int n = 0; n < 2; ++n) acc[a][b][m][n] = (f32x4){0.f, 0.f, 0.f, 0.f};
    bf16x8 At[4][2], B0[2][2], B1[2][2];
    const char* cA = cur.a; const char* cB = cur.b;
    PG8_STAGE(PG8_SB(0, 0), cB, voffB); PG8_STAGE(PG8_SB(0, 1), cB + hstep, voffB); PG8_STAGE(PG8_SA(0, 0), cA, voffA); PG8_STAGE(PG8_SA(0, 1), cA + hstep, voffA);
    if (wr == 1) PG8_BAR;
    PG8_WAIT_V(2); PG8_BAR;
    PG8_STAGE(PG8_SB(1, 0), cB + kstep, voffB); PG8_STAGE(PG8_SA(1, 0), cA + kstep, voffA); PG8_STAGE(PG8_SB(1, 1), cB + hstep + kstep, voffB);
    PG8_WAIT_V(6); PG8_BAR;
    for (;;) {
        const bool has_next = S.next(ui + 1, nxt);
        const char* nA = has_next ? nxt.a : cA; const char* nB = has_next ? nxt.b : cB;
        for (int t = 0; t < nt; t += 2) {
            if constexpr (Epi::KWAIT) { if (t == nt - 6 && E.need_wait(cur)) E.do_wait(cur, wid); }
            const bool last = (t == nt - 2);
            const char* a1 = cA + (size_t)(t + 1) * kstep;
            const char* a2 = last ? nA : cA + (size_t)(t + 2) * kstep; const char* b2 = last ? nB : cB + (size_t)(t + 2) * kstep;
            const char* a3 = a2 + kstep; const char* b3 = b2 + kstep;
            PG8_LDB(B0, 0, 0); PG8_LDB(B1, 0, 1); PG8_SCHED; PG8_LDA(At, 0, 0); PG8_STAGE(PG8_SA(1, 1), a1 + hstep, voffA);
            PG8_WAIT_V(8); PG8_WAIT_L(0); PG8_BAR; PG8_MMA(0, 0, At, B0); PG8_MMA(0, 1, At, B1); PG8_BAR; PG8_SCHED;
            PG8_LDA(At, 0, 1); PG8_STAGE(PG8_SB(0, 0), b2, voffB); PG8_STAGE(PG8_SB(0, 1), b2 + hstep, voffB); PG8_STAGE(PG8_SA(0, 0), a2, voffA);
            PG8_WAIT_V(8); PG8_WAIT_L(0); PG8_BAR; PG8_MMA(1, 0, At, B0); PG8_MMA(1, 1, At, B1); PG8_BAR; PG8_SCHED;
            PG8_LDB(B0, 1, 0); PG8_LDB(B1, 1, 1); PG8_SCHED; PG8_LDA(At, 1, 0); PG8_STAGE(PG8_SA(0, 1), a2 + hstep, voffA);
            PG8_WAIT_V(8); PG8_WAIT_L(0); PG8_BAR; PG8_MMA(0, 0, At, B0); PG8_MMA(0, 1, At, B1); PG8_BAR; PG8_SCHED;
            PG8_LDA(At, 1, 1); PG8_STAGE(PG8_SB(1, 0), b3, voffB); PG8_STAGE(PG8_SB(1, 1), b3 + hstep, voffB); PG8_STAGE(PG8_SA(1, 0), a3, voffA);
            PG8_WAIT_V(8); PG8_WAIT_L(0); PG8_BAR; PG8_MMA(1, 0, At, B0); PG8_MMA(1, 1, At, B1); PG8_BAR; PG8_SCHED;
        }
        if (wr == 0) PG8_BAR;
        E(acc, cur, wr, wc, fr, fq);
        if (!has_next) break;
#pragma unroll
        for (int a = 0; a < 2; ++a)
#pragma unroll
            for (int b = 0; b < 2; ++b)
#pragma unroll
                for (int m = 0; m < 4; ++m)
#pragma unroll
                    for (int n = 0; n < 2; ++n) acc[a][b][m][n] = (f32x4){0.f, 0.f, 0.f, 0.f};
        cur = nxt; cA = nA; cB = nB; ++ui;
        if (wr == 1) PG8_BAR;
    }
    PG8_WAIT_V(0);
    PG8_BAR;
#undef PG8_SA
#undef PG8_SB
#undef PG8_STAGE
#undef PG8_LDA
#undef PG8_LDB
#undef PG8_MMA
#undef PG8_WAIT_V
#undef PG8_WAIT_L
#undef PG8_BAR
#undef PG8_SCHED
}
}

struct EpiGU {
    static constexpr bool PERM = true, KWAIT = false; bf16_t* H; const float* rss; const float* sw;
    DI void operator()(const f32x4 (&acc)[2][2][4][2], const pg8::Unit& u, int wr, int wc, int fr, int fq) const {
        asm volatile("" : "+v"(fr), "+v"(fq));
        const int row0 = u.pm * 256 + wr * 64 + fr, col0 = u.pn * 128 + wc * 32 + 8 * fq;
        const int cond = u.pm < 32 ? 0 : 1 + ((u.pm - 32) >> 3);
        const float* swp = sw + cond * 5632 + u.pn * 256 + wc * 32 + 8 * fq;
        const f32x4 sg0 = *(const f32x4*)(swp), sg1 = *(const f32x4*)(swp + 4), su0 = *(const f32x4*)(swp + 128), su1 = *(const f32x4*)(swp + 132);
        float rs8[8];
#pragma unroll
        for (int it = 0; it < 8; ++it) rs8[it] = rss[row0 + (it >> 2) * 128 + (it & 3) * 16];
#pragma unroll
        for (int ai = 0; ai < 2; ++ai)
#pragma unroll
            for (int m = 0; m < 4; ++m) {
                const int row = row0 + ai * 128 + m * 16;
                const float rstd = rsqrtf(rs8[ai * 4 + m] * (1.f / D) + EPS);
                bf16_t* rowp = H + (size_t)row * FH + col0;
                const f32x4 g0 = acc[ai][0][m][0] * rstd + sg0, g1 = acc[ai][0][m][1] * rstd + sg1, u0 = acc[ai][1][m][0] * rstd + su0, u1 = acc[ai][1][m][1] * rstd + su1;
                u32x4 w;
                w.x = pk2(silu_f(g0[0]) * u0[0], silu_f(g0[1]) * u0[1]); w.y = pk2(silu_f(g0[2]) * u0[2], silu_f(g0[3]) * u0[3]);
                w.z = pk2(silu_f(g1[0]) * u1[0], silu_f(g1[1]) * u1[1]); w.w = pk2(silu_f(g1[2]) * u1[2], silu_f(g1[3]) * u1[3]);
                *(u32x4*)rowp = w;
                __builtin_amdgcn_sched_barrier(0);
            }
    }
};
struct EpiRes {
    static constexpr bool PERM = false, KWAIT = true; float* out; const float* mod; const float* normg; unsigned char* ws; const float* xp; const float* xs; int l, gidx, ni; unsigned* tcnt;
    DI bool need_wait(const pg8::Unit& u) const { return tcnt != nullptr && u.pm >= 32; }
    DI void do_wait(const pg8::Unit& u, int wid) const {
        if (wid == 0) { unsigned sp = 0; while ((unsigned)__builtin_amdgcn_readfirstlane(__hip_atomic_load(tcnt + (u.pm - 32) * 16, __ATOMIC_RELAXED, __HIP_MEMORY_SCOPE_AGENT)) < 2u) { __builtin_amdgcn_s_sleep(2); if (++sp > (1u << 22)) break; }
            __builtin_amdgcn_fence(__ATOMIC_ACQUIRE, "agent"); asm volatile("s_waitcnt vmcnt(0)" ::: "memory"); }
        asm volatile("" ::: "memory"); __builtin_amdgcn_s_barrier(); asm volatile("" ::: "memory");
    }
    DI void operator()(const f32x4 (&acc)[2][2][4][2], const pg8::Unit& u, int wr, int wc, int fr, int fq) const {
        asm volatile("" : "+v"(fr), "+v"(fq));
        const int cond = u.pm < 32 ? 0 : 1 + ((u.pm - 32) >> 3);
        const float* gate = mod + (size_t)l * 3 * NMOD + (cond * 9 + gidx) * D;
        const float w = gidx == 5 ? 1.f : 0.5f;
        const bool nn = ni >= 0; const int nl = nn ? ni / 3 : 0, nj = nn ? ni - 3 * nl : 0;
        const float* ng = normg + (nn ? ni : 0) * D; const float* nscale = mod + (size_t)nl * 3 * NMOD + (cond * 9 + 3 * nj + 1) * D;
        float* rss = (float*)(ws + WS_CTL + WS_RSS) + (nn ? ni : 0) * MTOK; bf16_t* xn = (bf16_t*)(ws + WS_XN);
        const int col0 = u.pn * 256 + wc * 32 + 4 * fq;
        f32x4 gv[2][2], gs[2][2];
#pragma unroll
        for (int bj = 0; bj < 2; ++bj)
#pragma unroll
            for (int n = 0; n < 2; ++n) { const int c = col0 + bj * 128 + n * 16; gv[bj][n] = *(const f32x4*)(gate + c) * w;
                gs[bj][n] = *(const f32x4*)(ng + c) * (*(const f32x4*)(nscale + c) + 1.f); }
        const int rowb = u.pm * 256 + wr * 64 + fr;
        const float* rb = (l == 0 && gidx == 2) ? (u.pm < 32 ? xp : xs - (size_t)MP * D) : out;
        f32x4 bn[2][2];
#pragma unroll
        for (int bj = 0; bj < 2; ++bj)
#pragma unroll
            for (int n = 0; n < 2; ++n) bn[bj][n] = *(const f32x4*)(rb + (size_t)rowb * D + col0 + bj * 128 + n * 16);
#pragma unroll
        for (int it = 0; it < 8; ++it) {
            const int ai = it >> 2, m = it & 3;
            const int row = rowb + ai * 128 + m * 16;
            float* op = out + (size_t)row * D; float ss = 0.f;
            f32x4 bc[2][2];
#pragma unroll
            for (int bj = 0; bj < 2; ++bj)
#pragma unroll
                for (int n = 0; n < 2; ++n) bc[bj][n] = bn[bj][n];
            if (it < 7) { const int rown = rowb + ((it + 1) >> 2) * 128 + ((it + 1) & 3) * 16;
#pragma unroll
                for (int bj = 0; bj < 2; ++bj)
#pragma unroll
                    for (int n = 0; n < 2; ++n) bn[bj][n] = *(const f32x4*)(rb + (size_t)rown * D + col0 + bj * 128 + n * 16); }
#pragma unroll
            for (int bj = 0; bj < 2; ++bj)
#pragma unroll
                for (int n = 0; n < 2; ++n) { const int c = col0 + bj * 128 + n * 16; const f32x4 o = bc[bj][n] + gv[bj][n] * acc[ai][bj][m][n]; *(f32x4*)(op + c) = o;
                    if (nn) { ss += (o[0] * o[0] + o[1] * o[1]) + (o[2] * o[2] + o[3] * o[3]); const f32x4 y = o * gs[bj][n]; u32x2 pw; pw.x = pk2(y[0], y[1]); pw.y = pk2(y[2], y[3]); *(u32x2*)(xn + (size_t)row * D + c) = pw; } }
            if (nn) { ss = xor32_sum(xor16_sum(ss)); if (fq == 0) atomicAdd(rss + row, ss); }
            __builtin_amdgcn_sched_barrier(0);
        }
    }
};
struct EpiQKV {
    static constexpr bool PERM = false, KWAIT = false;
    bf16_t *qk, *vt; float* out; const float* gtab; const float* rss; const float* sw;
    DI void operator()(const f32x4 (&acc)[2][2][4][2], const pg8::Unit& u, int wr, int wc, int fr, int fq) const {
        asm volatile("" : "+v"(fr), "+v"(fq));
        if (u.kind == 0) {
            const int slot = u.pn * 4 + wc;
            if (slot >= 26) return;
            const int type = slot < 8 ? 0 : slot < 16 ? 1 : slot < 24 ? 2 : 3;
            const int h = slot - (type == 0 ? 0 : type == 1 ? 8 : type == 2 ? 16 : 24);
            const float* g = gtab + type * 64;
            bf16_t* dst = qk + (size_t)slot * MTOK * 64;
            const float qs = (type == 0 || type == 2) ? 0.125f * LOG2E : 1.f;
            const bool rope = (type >= 2) && (u.pm >= 32);
            f32x4 gv[2][2];
#pragma unroll
            for (int bj = 0; bj < 2; ++bj)
#pragma unroll
                for (int n = 0; n < 2; ++n) gv[bj][n] = *(const f32x4*)(g + 32 * bj + 16 * n + 4 * fq);
            const int cond = u.pm < 32 ? 0 : 1 + ((u.pm - 32) >> 3);
            f32x4 sv[2][2];
#pragma unroll
            for (int bj = 0; bj < 2; ++bj)
#pragma unroll
                for (int n = 0; n < 2; ++n) sv[bj][n] = *(const f32x4*)(sw + cond * 2560 + u.pn * 256 + bj * 128 + wc * 32 + 16 * n + 4 * fq);
            float rs8[8];
#pragma unroll
            for (int it = 0; it < 8; ++it) rs8[it] = rss[u.pm * 256 + (it >> 2) * 128 + wr * 64 + (it & 3) * 16 + fr];
            float freq[4];
#pragma unroll
            for (int i = 0; i < 4; ++i) freq[i] = __builtin_amdgcn_exp2f(-(float)(4 * fq + i) * (0.0625f * 13.287712379549449f));
#pragma unroll
            for (int ai = 0; ai < 2; ++ai)
#pragma unroll
                for (int m = 0; m < 4; ++m) {
                    const int row = u.pm * 256 + ai * 128 + wr * 64 + m * 16 + fr;
                    f32x4 y[2][2]; float ss = 0.f; const float rin = rsqrtf(rs8[ai * 4 + m] * (1.f / D) + EPS);
#pragma unroll
                    for (int bj = 0; bj < 2; ++bj)
#pragma unroll
                        for (int n = 0; n < 2; ++n) { y[bj][n] = acc[ai][bj][m][n] * rin + sv[bj][n]; const f32x4 x = y[bj][n]; ss += (x[0] * x[0] + x[1] * x[1]) + (x[2] * x[2] + x[3] * x[3]); }
                    ss = xor32_sum(xor16_sum(ss));
                    const float rstd = rsqrtf(ss * (1.f / 64.f) + EPS);
#pragma unroll
                    for (int bj = 0; bj < 2; ++bj)
#pragma unroll
                        for (int n = 0; n < 2; ++n) y[bj][n] = y[bj][n] * rstd * gv[bj][n];
                    if (rope) {
                        const int t = (row - MP) & 2047;
#pragma unroll
                        for (int bj = 0; bj < 2; ++bj) {
                            const float pos = (float)(bj == 0 ? (t >> 6) : (t & 63));
#pragma unroll
                            for (int i = 0; i < 4; ++i) {
                                const float ang = pos * freq[i]; const float sn = __sinf(ang), cs = __cosf(ang);
                                const float x1 = y[bj][0][i], x2 = y[bj][1][i];
                                y[bj][0][i] = x1 * cs - x2 * sn; y[bj][1][i] = x1 * sn + x2 * cs;
                            }
                        }
                    }
                    if (u.pm < 32 && (type == 1 || type == 3)) {
                        const size_t oo = (type == 1 ? O_NAK + (size_t)row * 512 : O_GK + (size_t)row * 128) + h * 64;
                        float* o = out + oo;
#pragma unroll
                        for (int bj = 0; bj < 2; ++bj)
#pragma unroll
                            for (int n = 0; n < 2; ++n) *(f32x4*)(o + 32 * bj + 16 * n + 4 * fq) = y[bj][n];
                    }
                    bf16_t* dp = dst + (size_t)row * 64 + 4 * fq;
#pragma unroll
                    for (int bj = 0; bj < 2; ++bj)
#pragma unroll
                        for (int n = 0; n < 2; ++n) { const f32x4 v = y[bj][n] * qs; u32x2 w; w.x = pk2(v[0], v[1]); w.y = pk2(v[2], v[3]); *(u32x2*)(dp + 32 * bj + 16 * n) = w; }
                    __builtin_amdgcn_sched_barrier(0);
                }
        } else {
            const int condt = u.pn < 32 ? 0 : 1 + ((u.pn - 32) >> 3);
            f32x4 rt[2][2]; float sw8[8];
#pragma unroll
            for (int bj = 0; bj < 2; ++bj)
#pragma unroll
                for (int n = 0; n < 2; ++n) { const f32x4 q4 = *(const f32x4*)(rss + u.pn * 256 + bj * 128 + wc * 32 + 16 * n + 4 * fq);
#pragma unroll
                    for (int i = 0; i < 4; ++i) rt[bj][n][i] = rsqrtf(q4[i] * (1.f / D) + EPS); }
#pragma unroll
            for (int it = 0; it < 8; ++it) { const int dv = u.pm * 256 + (it >> 2) * 128 + wr * 64 + (it & 3) * 16 + fr; sw8[it] = sw[condt * 2560 + 1792 + (dv < 768 ? dv : 0)]; }
#pragma unroll
            for (int ai = 0; ai < 2; ++ai)
#pragma unroll
                for (int m = 0; m < 4; ++m) {
                    const int dv = u.pm * 256 + ai * 128 + wr * 64 + m * 16 + fr;
                    if (dv < 640) {
                        const float swv = sw8[ai * 4 + m];
#pragma unroll
                        for (int bj = 0; bj < 2; ++bj)
#pragma unroll
                            for (int n = 0; n < 2; ++n) {
                                const int tok0 = u.pn * 256 + bj * 128 + wc * 32 + 16 * n + 4 * fq;
                                const f32x4 v = acc[ai][bj][m][n] * rt[bj][n] + swv;
                                u32x2 w; w.x = pk2(v[0], v[1]); w.y = pk2(v[2], v[3]);
                                *(u32x2*)(vt + (size_t)dv * MTOK + tok0) = w;
                                if (u.pn < 32) {
                                    const int q = fr & 3; const f32x4 w4 = quad_transpose(v, q); const int dvb = dv - q;
                                    if (dv < 512) *(f32x4*)(out + O_NAV + (size_t)(tok0 + q) * 512 + dvb) = w4;
                                    else *(f32x4*)(out + O_GV + (size_t)(tok0 + q) * 128 + (dvb - 512)) = w4;
                                }
                            }
                    }
                    __builtin_amdgcn_sched_barrier(0);
                }
        }
    }
};
struct EpiSGU {
    static constexpr bool PERM = true, KWAIT = false; bf16_t* U; bf16_t* VTS; float* rowss; const float* rss; const float* sw;
    DI void operator()(const f32x4 (&acc)[2][2][4][2], const pg8::Unit& u, int wr, int wc, int fr, int fq) const {
        asm volatile("" : "+v"(fr), "+v"(fq));
        const int r0 = u.pm * 256 + wr * 64 + fr, c0 = u.pn * 256 + wc * 32 + 8 * fq;
        bf16_t* base = u.kind ? VTS : U; const size_t ld = u.kind ? (size_t)MTOK : (size_t)2048;
        const int condc = u.kind ? (u.pn < 32 ? 0 : 1 + ((u.pn - 32) >> 3)) : (u.pm < 32 ? 0 : 1 + ((u.pm - 32) >> 3));
        f32x4 cs[2][2];
#pragma unroll
        for (int bj = 0; bj < 2; ++bj)
#pragma unroll
            for (int n = 0; n < 2; ++n) {
                if (u.kind == 0) cs[bj][n] = *(const f32x4*)(sw + condc * 4096 + c0 + bj * 128 + 4 * n);
                else { const f32x4 q4 = *(const f32x4*)(rss + c0 + bj * 128 + 4 * n);
#pragma unroll
                    for (int i = 0; i < 4; ++i) cs[bj][n][i] = rsqrtf(q4[i] * (1.f / D) + EPS); }
            }
        f32x4 sq[2][2];
#pragma unroll
        for (int bj = 0; bj < 2; ++bj)
#pragma unroll
            for (int n = 0; n < 2; ++n) sq[bj][n] = (f32x4){0.f, 0.f, 0.f, 0.f};
        float rs8[8];
#pragma unroll
        for (int it = 0; it < 8; ++it) { const int row = r0 + (it >> 2) * 128 + (it & 3) * 16; rs8[it] = u.kind ? sw[condc * 4096 + 2048 + row] : rss[row]; }
#pragma unroll
        for (int ai = 0; ai < 2; ++ai)
#pragma unroll
            for (int m = 0; m < 4; ++m) {
                const int row = r0 + ai * 128 + m * 16;
                const float rsc = u.kind ? rs8[ai * 4 + m] : rsqrtf(rs8[ai * 4 + m] * (1.f / D) + EPS);
                bf16_t* rowp = base + (size_t)row * ld + c0;
#pragma unroll
                for (int bj = 0; bj < 2; ++bj) {
                    const f32x4 x0 = u.kind ? acc[ai][bj][m][0] * cs[bj][0] + rsc : acc[ai][bj][m][0] * rsc + cs[bj][0];
                    const f32x4 x1 = u.kind ? acc[ai][bj][m][1] * cs[bj][1] + rsc : acc[ai][bj][m][1] * rsc + cs[bj][1];
                    const f32x4 a = gelu4(x0), b = gelu4(x1);
                    sq[bj][0] += a * a; sq[bj][1] += b * b;
                    u32x4 w; w.x = pk2(a[0], a[1]); w.y = pk2(a[2], a[3]); w.z = pk2(b[0], b[1]); w.w = pk2(b[2], b[3]); *(u32x4*)(rowp + bj * 128) = w; }
                __builtin_amdgcn_sched_barrier(0);
            }
        if (u.kind) {
#pragma unroll
            for (int bj = 0; bj < 2; ++bj)
#pragma unroll
                for (int n = 0; n < 2; ++n)
#pragma unroll
                    for (int i = 0; i < 4; ++i) {
                        float s = sq[bj][n][i];
                        s = row16_sum(s);
                        if (fr == 0) atomicAdd(rowss + c0 + bj * 128 + 4 * n + i, s);
                    }
        }
    }
};

struct TItem { const float* src; bf16_t* dst0; bf16_t* dst1; int ldw, Kd; };
DI void titem_load(const TItem& t, int lane, float (&v)[64]) {
#pragma unroll
    for (int i = 0; i < 64; ++i) v[i] = t.src[(size_t)i * t.ldw + lane];
}
DI void titem_finish(const TItem& t, LAS float* scr, int lane, const float (&v)[64]) {
#pragma unroll
    for (int i = 0; i < 64; ++i) scr[i * 65 + lane] = v[i];
    asm volatile("s_waitcnt lgkmcnt(0)" ::: "memory");
    const int c = lane & 7;
#pragma unroll
    for (int j = 0; j < 8; ++j) { const int n = (lane >> 3) + 8 * j; const LAS float* s = scr + (8 * c) * 65 + n;
        u32x4 o; o.x = pk2(s[0 * 65], s[1 * 65]); o.y = pk2(s[2 * 65], s[3 * 65]); o.z = pk2(s[4 * 65], s[5 * 65]); o.w = pk2(s[6 * 65], s[7 * 65]);
        bf16_t* d = (j < 4 ? t.dst0 + (size_t)n * t.Kd : t.dst1 + (size_t)(n - 32) * t.Kd) + 8 * c;
        *(u32x4*)d = o; }
    asm volatile("s_waitcnt lgkmcnt(0)" ::: "memory");
}
DI void convert_list(const Params& p, unsigned char* ws, LAS unsigned char* lds, int mask, int gw, int ngw, int wid, int lane) {
    LAS float* scr = (LAS float*)(lds + wid * 16640);
    int NIT = 0;
#pragma unroll
    for (int m = 0; m < 12; ++m) { const int cnt = m < 4 ? 1408 : m < 8 ? 704 : m == 8 ? 576 : m == 9 ? 256 : m == 10 ? 1024 : 512; if ((mask >> m) & 1) NIT += cnt; }
    auto decode = [&](int a, TItem& t) {
        int mm = 0, r = a; bool found = false;
#pragma unroll
        for (int m = 0; m < 12; ++m) { const int cnt = m < 4 ? 1408 : m < 8 ? 704 : m == 8 ? 576 : m == 9 ? 256 : m == 10 ? 1024 : 512;
            if (!found && ((mask >> m) & 1)) { if (r < cnt) { mm = m; found = true; } else r -= cnt; } }
        const float* W; bf16_t* WT; int ldw, Kd, k0, n0, drow0, drow1;
        if (mm < 4) { const int mi = mm, l = mi >> 1, f = mi & 1;
            W = (f ? p.in[13] : p.in[11]) + (size_t)l * D * 5632; const int kb = r / 88, nb = r % 88; n0 = nb * 64; k0 = kb * 64; ldw = 5632; Kd = D;
            drow0 = n0 < FH ? (n0 >> 7) * 256 + (n0 & 127) : ((n0 - FH) >> 7) * 256 + 128 + ((n0 - FH) & 127); drow1 = drow0 + 32;
            WT = (bf16_t*)(ws + WS_W + (size_t)mi * FFN_STRIDE); }
        else if (mm < 8) { const int mi = mm - 4, l = mi >> 1, f = mi & 1;
            W = (f ? p.in[14] : p.in[12]) + (size_t)l * FH * D; const int kb = r / 16, nb = r % 16; n0 = nb * 64; k0 = kb * 64; ldw = D; Kd = FH; drow0 = n0; drow1 = n0 + 32;
            WT = (bf16_t*)(ws + WS_W + (size_t)mi * FFN_STRIDE + FFN_DOWN); }
        else if (mm == 8) { const int kb = r / 36, slot = r % 36; n0 = slot * 64; k0 = kb * 64; ldw = 2304; Kd = D; W = p.in[15];
            if (slot >= 16 && slot < 24) { WT = (bf16_t*)(ws + WS_WV); drow0 = (slot - 16) * 64; drow1 = drow0 + 32; }
            else if (slot >= 34) { WT = (bf16_t*)(ws + WS_WV); drow0 = 512 + (slot - 34) * 64; drow1 = drow0 + 32; }
            else { const int q = slot < 16 ? slot : slot - 8; WT = (bf16_t*)(ws + WS_WQK); drow0 = (q >> 2) * 256 + 32 * (q & 3); drow1 = drow0 + 128; } }
        else if (mm == 9) { const int kb = r / 16, nb = r % 16; n0 = nb * 64; k0 = kb * 64; ldw = D; Kd = D; W = p.in[16]; WT = (bf16_t*)(ws + WS_WO); drow0 = n0; drow1 = n0 + 32; }
        else if (mm == 10) { const int kb = r / 64, nb = r % 64; n0 = nb * 64; k0 = kb * 64; ldw = 4096; Kd = D; W = p.in[22]; WT = (bf16_t*)(ws + WS_WSI); drow0 = n0; drow1 = n0 + 32; }
        else { const int kb = r / 16, nb = r % 16; n0 = nb * 64; k0 = kb * 64; ldw = D; Kd = 2048; W = p.in[26]; WT = (bf16_t*)(ws + WS_WSO); drow0 = n0; drow1 = n0 + 32; }
        t.src = W + (size_t)k0 * ldw + n0; t.dst0 = WT + (size_t)drow0 * Kd + k0; t.dst1 = WT + (size_t)drow1 * Kd + k0; t.ldw = ldw; t.Kd = Kd;
    };
    for (int it = gw; it < NIT; it += ngw) { TItem cur; float vc[64]; decode(it, cur); titem_load(cur, lane, vc); titem_finish(cur, scr, lane, vc); }
}
DI void mod_gemv(const Params& p, unsigned char* ws, LAS unsigned char* lds, int l_lo, int l_hi, int gw, int ngw, int tid, int lane) {
    LAS float* silu = (LAS float*)lds;
    for (int i = tid; i < 3072; i += 512) { const int ci = i >> 10, k = i & 1023; const float x = ci == 0 ? p.in[7][k] : p.in[6][(ci - 1) * D + k]; silu[i] = x / (1.f + __expf(-x)); }
    __syncthreads();
    float* mod = (float*)(ws + WS_MOD);
    const int ntask = (l_hi - l_lo) * 4608;
    for (int id = gw; id < ntask; id += ngw) {
        const int l = l_lo + id / 4608, r = id % 4608, kc = r / 144, st = r - kc * 144, n0 = st * 64, k0 = kc * 32;
        const float* w = p.in[9] + (size_t)l * D * NMOD + (size_t)k0 * NMOD + n0 + lane;
        float wv[32];
#pragma unroll
        for (int kk = 0; kk < 32; ++kk) wv[kk] = w[(size_t)kk * NMOD];
        float a0 = 0.f, a1 = 0.f, a2 = 0.f;
#pragma unroll
        for (int kk = 0; kk < 32; ++kk) { a0 += silu[k0 + kk] * wv[kk]; a1 += silu[1024 + k0 + kk] * wv[kk]; a2 += silu[2048 + k0 + kk] * wv[kk]; }
        if (kc == 0) { const float bb = p.in[10][l * NMOD + n0 + lane]; a0 += bb; a1 += bb; a2 += bb; }
        atomicAdd(mod + (size_t)(l * 3 + 0) * NMOD + n0 + lane, a0); atomicAdd(mod + (size_t)(l * 3 + 1) * NMOD + n0 + lane, a1); atomicAdd(mod + (size_t)(l * 3 + 2) * NMOD + n0 + lane, a2);
    }
    __syncthreads();
}
DI void conv_caches(const Params& p, unsigned char* ws, int gt, int nth) {
    bf16_t* kcna = (bf16_t*)(ws + WS_KCNA); bf16_t* vcnat = (bf16_t*)(ws + WS_VCNAT); bf16_t* kcg = (bf16_t*)(ws + WS_KCG); bf16_t* vcgt = (bf16_t*)(ws + WS_VCGT);
    for (int i = gt; i < 524288; i += nth) {
        { const int d = i & 63, l = (i >> 6) & 511, h = (i >> 15) & 7, b = i >> 18; kcna[i] = (bf16_t)pk2(p.in[2][((size_t)(b * 512 + l) * 8 + h) * 64 + d], 0.f); }
        { const int l = i & 511, d = (i >> 9) & 63, h = (i >> 15) & 7, b = i >> 18; vcnat[i] = (bf16_t)pk2(p.in[3][((size_t)(b * 512 + l) * 8 + h) * 64 + d], 0.f); }
    }
    for (int i = gt; i < 131072; i += nth) {
        { const int d = i & 63, l = (i >> 6) & 511, kv = (i >> 15) & 1, b = i >> 16; kcg[i] = (bf16_t)pk2(p.in[4][((size_t)(b * 512 + l) * 2 + kv) * 64 + d], 0.f); }
        { const int l = i & 511, d = (i >> 9) & 63, kv = (i >> 15) & 1, b = i >> 16; vcgt[i] = (bf16_t)pk2(p.in[5][((size_t)(b * 512 + l) * 2 + kv) * 64 + d], 0.f); }
    }
}
DI void prep_phase(const Params& p, unsigned char* ws, LAS unsigned char* lds, int tid, int wid, int lane, int cb, int G) {
    mod_gemv(p, ws, lds, 0, G > 192 ? 1 : 2, cb * 8 + wid, G * 8, tid, lane);
    {
        const int gt = cb * 512 + tid, nth = G * 512;
        if (G <= 192) conv_caches(p, ws, gt, nth);
        unsigned* z0a = (unsigned*)(ws + WS_WQK + (size_t)1600 * D * 2); unsigned* z0b = (unsigned*)(ws + WS_WQK + (size_t)1728 * D * 2); unsigned* z1 = (unsigned*)(ws + WS_WV + (size_t)640 * D * 2);
        for (int i = gt; i < 65536; i += nth) { if (i < 32768) z0a[i] = 0u; else z0b[i - 32768] = 0u; z1[i] = 0u; }
        if (gt < 256) { const int ty = gt >> 6, d = gt & 63; ((float*)(ws + WS_GTAB))[gt] = ty == 0 ? p.in[17][d] : ty == 1 ? p.in[18][d] : ty == 2 ? p.in[20][d] : p.in[21][d]; }
    }
    convert_list(p, ws, lds, G > 192 ? 0x111 : 0xfff, cb * 8 + wid, G * 8, wid, lane);
}

DI void sw_rows(const Params& p, unsigned char* ws, int sel, int gw, int ngw, int lane) {
    float* swb = (float*)(ws + WS_SW); const float* mod = (const float*)(ws + WS_MOD);
#pragma unroll 1
    for (int ci = 0; ci < 7; ++ci) {
        if (!((sel >> ci) & 1)) continue;
        const bf16_t* W; int l, j, nrows, cstride; float* o;
        if (ci < 4) { W = (const bf16_t*)(ws + WS_W + (size_t)ci * FFN_STRIDE); l = ci >> 1; j = (ci & 1) ? 2 : 0; o = swb + ci * 3 * 5632; cstride = 5632; nrows = 5632; }
        else if (ci == 4) { W = (const bf16_t*)(ws + WS_WQK); l = 0; j = 1; o = swb + SW_QKV; cstride = 2560; nrows = 1792; }
        else if (ci == 5) { W = (const bf16_t*)(ws + WS_WV); l = 0; j = 1; o = swb + SW_QKV + 1792; cstride = 2560; nrows = 768; }
        else { W = (const bf16_t*)(ws + WS_WSI); l = 1; j = 1; o = swb + SW_SGU; cstride = 4096; nrows = 4096; }
        f32x4 sh[3][4];
#pragma unroll
        for (int c = 0; c < 3; ++c)
#pragma unroll
            for (int q = 0; q < 4; ++q) sh[c][q] = *(const f32x4*)(mod + (size_t)(l * 3 + c) * NMOD + 3 * j * D + lane * 16 + 4 * q);
        for (int row = gw; row < nrows; row += ngw) {
            const u32x4 w0 = *(const u32x4*)(W + (size_t)row * D + lane * 16), w1 = *(const u32x4*)(W + (size_t)row * D + lane * 16 + 8);
            float wf[16];
#pragma unroll
            for (int i = 0; i < 4; ++i) { wf[2 * i] = __builtin_bit_cast(float, w0[i] << 16); wf[2 * i + 1] = __builtin_bit_cast(float, w0[i] & 0xffff0000u);
                                          wf[8 + 2 * i] = __builtin_bit_cast(float, w1[i] << 16); wf[8 + 2 * i + 1] = __builtin_bit_cast(float, w1[i] & 0xffff0000u); }
            float a3[3];
#pragma unroll
            for (int c = 0; c < 3; ++c) { float a = 0.f;
#pragma unroll
                for (int q = 0; q < 4; ++q) a += (wf[4 * q] * sh[c][q][0] + wf[4 * q + 1] * sh[c][q][1]) + (wf[4 * q + 2] * sh[c][q][2] + wf[4 * q + 3] * sh[c][q][3]);
                a3[c] = wave_sum(a); }
            if (lane < 3) o[lane * cstride + row] = lane == 0 ? a3[0] : lane == 1 ? a3[1] : a3[2];
        }
    }
}

DI void phase1(const Params& p, unsigned char* ws, int gw, int ngw, int lane) {
    const float* mod = (const float*)(ws + WS_MOD);
    {
        const float* g = p.in[8];
        bf16_t* xn = (bf16_t*)(ws + WS_XN); float* rss0 = (float*)(ws + WS_CTL + WS_RSS);
        for (int m = gw; m < MTOK; m += ngw) {
            const int cond = m < MP ? 0 : 1 + ((m - MP) >> 11);
            const float* row = m < MP ? p.in[0] + (size_t)m * D : p.in[1] + (size_t)(m - MP) * D;
            const float* sc = mod + (cond * 9 + 1) * D;
            f32x4 v[4]; float ss = 0.f;
#pragma unroll
            for (int jj = 0; jj < 4; ++jj) { v[jj] = *(const f32x4*)(row + 4 * lane + 256 * jj); ss += (v[jj][0] * v[jj][0] + v[jj][1] * v[jj][1]) + (v[jj][2] * v[jj][2] + v[jj][3] * v[jj][3]); }
            ss = wave_sum(ss);
            if (lane == 0) rss0[m] = ss;
#pragma unroll
            for (int jj = 0; jj < 4; ++jj) { const int col = 4 * lane + 256 * jj;
                const f32x4 gg = *(const f32x4*)(g + col), s1 = *(const f32x4*)(sc + col);
                const f32x4 y = v[jj] * gg * (s1 + 1.f);
                u32x2 w; w.x = pk2(y[0], y[1]); w.y = pk2(y[2], y[3]); *(u32x2*)(xn + (size_t)m * D + col) = w; }
        }
    }
    sw_rows(p, ws, ngw > 1536 ? 0x31 : 0x7f, gw, ngw, lane);
}

#define MFMA32(a, b, c) __builtin_amdgcn_mfma_f32_32x32x16_bf16((a), (b), (c), 0, 0, 0)
constexpr int AT_ROW = 144;
constexpr int AT_KBUF = 0, AT_VBUF = 2 * 64 * AT_ROW, AT_RPB = 4 * 64 * AT_ROW, AT_TASK = AT_RPB + 2048;
struct ATask { const bf16_t* k0; const bf16_t* vt0; const bf16_t* kc; const bf16_t* vtc; int type, nsteps, urow0; };
DI void at_src(const ATask& T, int u, const bf16_t*& k, const bf16_t*& vt, int& vld) {
    if (T.type == 0) { k = T.k0 + (size_t)u * 4096; vt = T.vt0 + u * 64; vld = MTOK; }
    else if (T.type == 1) { if (u < 32) { k = T.k0 + (size_t)u * 4096; vt = T.vt0 + u * 64; vld = MTOK; } else { k = T.kc + (size_t)(u - 32) * 4096; vt = T.vtc + (u - 32) * 64; vld = 512; } }
    else { if (u < 8) { k = T.kc + (size_t)u * 4096; vt = T.vtc + u * 64; vld = 512; } else { const int tok = (T.urow0 + (u - 8)) * 64; k = T.k0 + (size_t)tok * 64; vt = T.vt0 + tok; vld = MTOK; } }
}
DI void at_gload(const ATask& T, int u, int tid, u32x4& a, u32x4& b) {
    const bf16_t* k; const bf16_t* vt; int vld; at_src(T, u, k, vt, vld);
    if (tid < 256) { const bf16_t* p = k + (tid >> 3) * 64 + (tid & 7) * 8; a = *(const u32x4*)p; b = *(const u32x4*)(p + 32 * 64); }
    else { const int j = tid - 256; const bf16_t* p = vt + (size_t)(j >> 2) * vld + (j & 3) * 8; a = *(const u32x4*)p; b = *(const u32x4*)(p + 32); }
}
DI void at_lstore(LAS unsigned char* lds, int buf, int tid, u32x4 a, u32x4 b) {
    if (tid < 256) { LAS unsigned char* p = lds + AT_KBUF + buf * 64 * AT_ROW + (tid >> 3) * AT_ROW + (tid & 7) * 16; *(LAS u32x4*)p = a; *(LAS u32x4*)(p + 32 * AT_ROW) = b; }
    else { const int j = tid - 256, c = j & 3, s = c >> 1, sec = c & 1; LAS unsigned char* row = lds + AT_VBUF + buf * 64 * AT_ROW + (j >> 2) * AT_ROW;
        const int o0 = ((s * 2 + 0) * 2 + sec) * 8, o1 = ((s * 2 + 1) * 2 + sec) * 8;
        *(LAS u32x2*)(row + o0) = (u32x2){a.x, a.y}; *(LAS u32x2*)(row + o1) = (u32x2){a.z, a.w};
        *(LAS u32x2*)(row + 64 + o0) = (u32x2){b.x, b.y}; *(LAS u32x2*)(row + 64 + o1) = (u32x2){b.z, b.w}; }
}
DI void attn_phase(const Params& p, unsigned char* ws, LAS unsigned char* lds, int tid, int wid, int lane, int rep) {
    unsigned char* R = ws + WS_R;
    const bf16_t* QNA = (const bf16_t*)(R + R_QNA); const bf16_t* KNA = (const bf16_t*)(R + R_KNA); const bf16_t* QG = (const bf16_t*)(R + R_QG); const bf16_t* KG = (const bf16_t*)(R + R_KG);
    const bf16_t* VT = (const bf16_t*)(R + R_VT); bf16_t* AO = (bf16_t*)(R + R_AO);
    const bf16_t* KCNA = (const bf16_t*)(ws + WS_KCNA); const bf16_t* VCNAT = (const bf16_t*)(ws + WS_VCNAT); const bf16_t* KCG = (const bf16_t*)(ws + WS_KCG); const bf16_t* VCGT = (const bf16_t*)(ws + WS_VCGT);
    unsigned* counter = (unsigned*)(ws + WS_CTL) + 64 * rep;
    LAS float* rpb_l = (LAS float*)(lds + AT_RPB); volatile LAS int* taskw = (volatile LAS int*)(lds + AT_TASK);
    const int r32 = lane & 31, hi = lane >> 5;
    for (;;) {
        if (tid == 0) taskw[0] = (int)atomicAdd(counter, 1u);
        __syncthreads();
        const int t = __builtin_amdgcn_readfirstlane(taskw[0]);
        if (t >= 768) break;
        ATask T; T.kc = nullptr; T.vtc = nullptr; T.urow0 = 0;
        const bf16_t* q; bf16_t* o; int r = 0, cblk = 0, row0 = 0;
        if (t < 128) {
            const int b = t >> 6, kv = (t >> 5) & 1, grp = t & 31, qh = kv * 4 + (grp >> 3), qb = (grp & 7) * 8 + wid, tok0 = MP + b * 2048;
            q = QG + ((size_t)qh * MTOK + tok0 + qb * 32) * 64; T.k0 = KG + ((size_t)kv * MTOK + tok0) * 64; T.vt0 = VT + (size_t)(512 + kv * 64) * MTOK + tok0;
            T.kc = KCG + (size_t)((b * 2 + kv) * 512) * 64; T.vtc = VCGT + (size_t)((b * 2 + kv) * 64) * 512; o = AO + (size_t)(tok0 + qb * 32) * D + 512 + qh * 64; T.type = 1; T.nsteps = 40;
        } else if (t < 256) {
            const int i = t - 128, b = i >> 6, h = (i >> 3) & 7, rg = i & 7, tok0 = MP + b * 2048;
            r = 4 * rg + (wid >> 1); cblk = wid & 1; row0 = min(max(r - 4, 0), 24);
            T.urow0 = min(max(4 * rg - 4, 0), 24); const int urow1 = min(max(4 * rg - 1, 0), 24) + 7;
            const int qb = r * 2 + cblk;
            q = QNA + ((size_t)h * MTOK + tok0 + qb * 32) * 64; T.k0 = KNA + ((size_t)h * MTOK + tok0) * 64; T.vt0 = VT + (size_t)(h * 64) * MTOK + tok0;
            T.kc = KCNA + (size_t)((b * 8 + h) * 512) * 64; T.vtc = VCNAT + (size_t)((b * 8 + h) * 64) * 512; o = AO + (size_t)(tok0 + qb * 32) * D + h * 64; T.type = 2; T.nsteps = 8 + (urow1 - T.urow0 + 1);
            if (tid < 465) rpb_l[tid] = p.in[19][h * 465 + tid] * LOG2E;
        } else {
            const int i = t - 256, isB = i >> 8, j = i & 255, b = j >> 3, h = j & 7, tok0 = b * 256, qb = wid;
            if (!isB) { q = QNA + ((size_t)h * MTOK + tok0 + qb * 32) * 64; T.k0 = KNA + ((size_t)h * MTOK + tok0) * 64; T.vt0 = VT + (size_t)(h * 64) * MTOK + tok0; o = AO + (size_t)(tok0 + qb * 32) * D + h * 64; }
            else { const int kv = h >> 2; q = QG + ((size_t)h * MTOK + tok0 + qb * 32) * 64; T.k0 = KG + ((size_t)kv * MTOK + tok0) * 64; T.vt0 = VT + (size_t)(512 + kv * 64) * MTOK + tok0; o = AO + (size_t)(tok0 + qb * 32) * D + 512 + h * 64; }
            T.type = 0; T.nsteps = 4;
        }
        const int ns = T.nsteps;
        u32x4 pa, pb, pc, pd; at_gload(T, 0, tid, pc, pd); at_gload(T, 1, tid, pa, pb);
        bf16x8 qf[4];
#pragma unroll
        for (int ks = 0; ks < 4; ++ks) qf[ks] = *(const bf16x8*)(q + r32 * 64 + ks * 16 + hi * 8);
        at_lstore(lds, 0, tid, pc, pd);
        float mrun = -1e30f, lrun = 0.f; f32x16 o0, o1;
#pragma unroll
        for (int i = 0; i < 16; ++i) { o0[i] = 0.f; o1[i] = 0.f; }
        __syncthreads();
        for (int u = 0; u < ns; ++u) {
            if (u + 1 < ns) at_lstore(lds, (u + 1) & 1, tid, pa, pb);
            if (u + 2 < ns) at_gload(T, u + 2, tid, pa, pb);
            bool active = true; const bool local = (T.type == 2 && u >= 8); int kr = 0;
            if (local) { kr = T.urow0 + (u - 8); active = (kr >= row0) && (kr < row0 + 8); }
            if (active) {
                const LAS unsigned char* kb = lds + AT_KBUF + (u & 1) * 64 * AT_ROW + r32 * AT_ROW + hi * 16;
                const LAS unsigned char* vb = lds + AT_VBUF + (u & 1) * 64 * AT_ROW + r32 * AT_ROW + hi * 16;
                f32x16 st[2];
#pragma unroll
                for (int h2 = 0; h2 < 2; ++h2) {
                    bf16x8 kf[4];
#pragma unroll
                    for (int ks = 0; ks < 4; ++ks) kf[ks] = *(const LAS bf16x8*)(kb + h2 * 32 * AT_ROW + ks * 32);
#pragma unroll
                    for (int i = 0; i < 16; ++i) st[h2][i] = 0.f;
#pragma unroll
                    for (int ks = 0; ks < 4; ++ks) st[h2] = MFMA32(kf[ks], qf[ks], st[h2]);
                }
                if (local) {
                    const int dr = kr - r + 7; const int qc = 32 * cblk + r32; const int wsq = min(max(qc - 8, 0), 48);
#pragma unroll
                    for (int h2 = 0; h2 < 2; ++h2) {
                        const int base = dr * 31 + 15 - qc + 32 * h2 + 4 * hi;
#pragma unroll
                        for (int i = 0; i < 16; ++i) { const int ko = (i & 3) + 8 * (i >> 2); const int kc = 32 * h2 + 4 * hi + ko; const bool ok = (kc >= wsq) && (kc < wsq + 16);
                            const float bias = rpb_l[ok ? base + ko : 0]; st[h2][i] = ok ? st[h2][i] + bias : -1e30f; }
                    }
                }
                float mx = fmaxf(fmaxf(st[0][0], st[0][1]), fmaxf(st[1][0], st[1][1]));
#pragma unroll
                for (int i = 2; i < 16; i += 2) mx = fmaxf(mx, fmaxf(fmaxf(st[0][i], st[0][i + 1]), fmaxf(st[1][i], st[1][i + 1])));
                mx = xor32_max(mx);
                if (__any(mx > mrun)) {
                    const float mnew = fmaxf(mrun, mx), alpha = __builtin_amdgcn_exp2f(mrun - mnew); mrun = mnew;
                    lrun *= alpha;
#pragma unroll
                    for (int i = 0; i < 16; ++i) { o0[i] *= alpha; o1[i] *= alpha; }
                }
                float ps0 = 0.f, ps1 = 0.f;
#pragma unroll
                for (int i = 0; i < 16; ++i) { st[0][i] = __builtin_amdgcn_exp2f(st[0][i] - mrun); ps0 += st[0][i]; st[1][i] = __builtin_amdgcn_exp2f(st[1][i] - mrun); ps1 += st[1][i]; }
                lrun += ps0 + ps1;
#pragma unroll
                for (int h2 = 0; h2 < 2; ++h2) {
                    u32x4 p0, p1;
                    p0.x = pk2(st[h2][0], st[h2][1]); p0.y = pk2(st[h2][2], st[h2][3]); p0.z = pk2(st[h2][4], st[h2][5]); p0.w = pk2(st[h2][6], st[h2][7]);
                    p1.x = pk2(st[h2][8], st[h2][9]); p1.y = pk2(st[h2][10], st[h2][11]); p1.z = pk2(st[h2][12], st[h2][13]); p1.w = pk2(st[h2][14], st[h2][15]);
                    const bf16x8 pf0 = __builtin_bit_cast(bf16x8, p0), pf1 = __builtin_bit_cast(bf16x8, p1);
                    bf16x8 vf[4];
#pragma unroll
                    for (int db = 0; db < 2; ++db)
#pragma unroll
                        for (int s = 0; s < 2; ++s) vf[db * 2 + s] = *(const LAS bf16x8*)(vb + db * 32 * AT_ROW + h2 * 64 + s * 32);
                    o0 = MFMA32(vf[0], pf0, o0); o0 = MFMA32(vf[1], pf1, o0);
                    o1 = MFMA32(vf[2], pf0, o1); o1 = MFMA32(vf[3], pf1, o1);
                }
            }
            __syncthreads();
        }
        lrun = xor32_sum(lrun);
        const float inv = 1.f / lrun;
        bf16_t* op = o + (size_t)r32 * D + 4 * hi;
#pragma unroll
        for (int gq = 0; gq < 4; ++gq) {
            u32x2 w0, w1;
            w0.x = pk2(o0[4 * gq] * inv, o0[4 * gq + 1] * inv); w0.y = pk2(o0[4 * gq + 2] * inv, o0[4 * gq + 3] * inv);
            w1.x = pk2(o1[4 * gq] * inv, o1[4 * gq + 1] * inv); w1.y = pk2(o1[4 * gq + 2] * inv, o1[4 * gq + 3] * inv);
            *(u32x2*)(op + 8 * gq) = w0; *(u32x2*)(op + 32 + 8 * gq) = w1;
        }
    }
}

DI void spatial_phase(const Params& p, unsigned char* ws, int wid, int lane, int cb, int G) {
    unsigned char* R = ws + WS_R;
    bf16_t* U = (bf16_t*)(R + R_U); const bf16_t* VTS = (const bf16_t*)(R + R_VTS);
    const float* rowss = (const float*)(ws + WS_CTL + 4096);
    const float* Ws = p.in[24]; const float* bs = p.in[25]; const float* vg = p.in[23];
    const int r32 = lane & 31, hi = lane >> 5, tb = wid & 3, dh = wid >> 2;
    for (int unit = cb; unit < 768; unit += G) {
        const int c = unit >> 3, g = unit & 7;
        bf16x8 bfr[8];
        const float* wsr = Ws + ((size_t)g * 128 + 32 * tb + r32) * 128;
#pragma unroll
        for (int ks = 0; ks < 8; ++ks) { const int s0 = 16 * ks + 8 * hi;
            const f32x4 w0 = *(const f32x4*)(wsr + s0), w1 = *(const f32x4*)(wsr + s0 + 4);
            const f32x4 q0 = *(const f32x4*)(rowss + 128 * c + s0), q1 = *(const f32x4*)(rowss + 128 * c + s0 + 4);
            f32x4 r0, r1;
#pragma unroll
            for (int i = 0; i < 4; ++i) { r0[i] = rsqrtf(q0[i] * (1.f / 2048.f) + EPS); r1[i] = rsqrtf(q1[i] * (1.f / 2048.f) + EPS); }
            u32x4 w; w.x = pk2(w0[0] * r0[0], w0[1] * r0[1]); w.y = pk2(w0[2] * r0[2], w0[3] * r0[3]); w.z = pk2(w1[0] * r1[0], w1[1] * r1[1]); w.w = pk2(w1[2] * r1[2], w1[3] * r1[3]);
            bfr[ks] = __builtin_bit_cast(bf16x8, w); }
        const int t = 128 * c + 32 * tb + r32; const float bias = bs[g * 128 + 32 * tb + r32];
#pragma unroll 1
        for (int db = 0; db < 4; ++db) {
            f32x16 acc;
#pragma unroll
            for (int i = 0; i < 16; ++i) acc[i] = 0.f;
            const bf16_t* vrow = VTS + (size_t)(256 * g + 128 * dh + 32 * db + r32) * MTOK + 128 * c + 8 * hi;
#pragma unroll
            for (int ks = 0; ks < 8; ++ks) { const bf16x8 a = *(const bf16x8*)(vrow + 16 * ks); acc = MFMA32(a, bfr[ks], acc); }
#pragma unroll
            for (int gq = 0; gq < 4; ++gq) { const int d = 256 * g + 128 * dh + 32 * db + 8 * gq + 4 * hi;
                const f32x4 vg4 = *(const f32x4*)(vg + d); bf16_t* up = U + (size_t)t * 2048 + d; const u32x2 uu = *(const u32x2*)up;
                const float u0 = bf2f((unsigned short)(uu.x & 0xffffu)), u1 = bf2f((unsigned short)(uu.x >> 16)), u2 = bf2f((unsigned short)(uu.y & 0xffffu)), u3 = bf2f((unsigned short)(uu.y >> 16));
                u32x2 w; w.x = pk2(u0 * (acc[4 * gq] * vg4[0] + bias), u1 * (acc[4 * gq + 1] * vg4[1] + bias)); w.y = pk2(u2 * (acc[4 * gq + 2] * vg4[2] + bias), u3 * (acc[4 * gq + 3] * vg4[3] + bias));
                *(u32x2*)up = w; }
        }
    }
}

#define XB_TMO      128
#define XB_XCNT(j)  (256  + 64 * (j))
#define XB_XSUB(j)  (1280 + 64 * (j))
#define XB_XGEN(j)  (2304 + 64 * (j))
#define XB_TOP      3328
#define XB_TOPGEN   3392
#define XCD_BAR_WORDS 3456
#define XB_SPIN_CAP (1u << 18)
DI unsigned xb_ld(unsigned* p)              { return __hip_atomic_load(p, __ATOMIC_RELAXED, __HIP_MEMORY_SCOPE_AGENT); }
DI unsigned xb_add(unsigned* p, unsigned v) { return __hip_atomic_fetch_add(p, v, __ATOMIC_RELAXED, __HIP_MEMORY_SCOPE_AGENT); }
DI unsigned xb_xcc_id() { return (unsigned)__builtin_amdgcn_s_getreg((3 << 11) | 20) & 0xFu; }
#define XB_SPIN(cond, bar) do { unsigned _sp = 0; while (cond) { __builtin_amdgcn_s_sleep(1); \
    if ((++_sp & 255u) == 0u) { if (xb_ld(&(bar)[XB_TMO])) break; if (_sp > XB_SPIN_CAP) { atomicAdd(&(bar)[XB_TMO], 1u); break; } } } } while (0)
struct XcdBarrier { unsigned* bar; unsigned x; volatile LAS unsigned* st; };
DI XcdBarrier xcd_barrier_post(unsigned* bar, volatile LAS unsigned* st, int tid) {
    XcdBarrier b; b.bar = bar; b.x = xb_xcc_id(); b.st = st;
    if (tid == 0) (void)xb_add(&bar[XB_XCNT(b.x)], 1u);
    return b;
}
DI void xcd_barrier_complete(unsigned* bar, unsigned x, unsigned& nloc, unsigned& nx) {
    const unsigned G = gridDim.x * gridDim.y * gridDim.z;
    unsigned sum, cnt, mine, sp = 0u;
    for (;;) {
        sum = 0u; cnt = 0u; mine = 0u;
#pragma unroll
        for (unsigned j = 0; j < 16; ++j) { const unsigned c = xb_ld(&bar[XB_XCNT(j)]); sum += c; cnt += (c > 0u) ? 1u : 0u; mine = (j == x) ? c : mine; }
        if (sum == G) break;
        __builtin_amdgcn_s_sleep(1);
        if ((++sp & 255u) == 0u) { if (xb_ld(&bar[XB_TMO])) break; if (sp > XB_SPIN_CAP) { atomicAdd(&bar[XB_TMO], 1u); break; } }
    }
    nloc = mine > 0u ? mine : 1u; nx = cnt > 0u ? cnt : 1u;
}
DI void xcd_barrier(const XcdBarrier& b, int tid) {
    asm volatile("s_waitcnt vmcnt(0)" ::: "memory");
    __syncthreads();
    if (tid == 0) {
        unsigned* bar = b.bar;
        __builtin_amdgcn_s_waitcnt(0);
        unsigned nloc = b.st[0], nx = b.st[1];
        if (nloc == 0u) { xcd_barrier_complete(bar, b.x, nloc, nx); b.st[0] = nloc; b.st[1] = nx; }
        const unsigned old = xb_add(&bar[XB_XSUB(b.x)], 1u);
        const unsigned gen = old / nloc;
        if (old + 1u == (gen + 1u) * nloc) {
            __builtin_amdgcn_fence(__ATOMIC_RELEASE, "agent");
            asm volatile("s_waitcnt vmcnt(0)" ::: "memory");
            const unsigned og = xb_add(&bar[XB_TOP], 1u);
            const unsigned tg = og / nx;
            if (og + 1u == (tg + 1u) * nx) xb_add(&bar[XB_TOPGEN], 1u);
            else XB_SPIN(xb_ld(&bar[XB_TOPGEN]) == tg, bar);
            __builtin_amdgcn_fence(__ATOMIC_ACQUIRE, "agent");
            xb_add(&bar[XB_XGEN(b.x)], 1u);
            asm volatile("s_waitcnt vmcnt(0)" ::: "memory");
        } else {
            XB_SPIN(xb_ld(&bar[XB_XGEN(b.x)]) == gen, bar);
            __builtin_amdgcn_fence(__ATOMIC_ACQUIRE, "agent");
            asm volatile("s_waitcnt vmcnt(0)" ::: "memory");
        }
    }
    __syncthreads();
}

__global__ void __launch_bounds__(512, 2) mega_fwd(Params p) {
    extern __shared__ __attribute__((aligned(16))) unsigned char lds_raw[];
    LAS unsigned char* lds = (LAS unsigned char*)lds_raw;
    volatile LAS unsigned* misc = (volatile LAS unsigned*)(lds + LDS_BYTES - 64);
    const int wave_s = __builtin_amdgcn_readfirstlane((int)threadIdx.x >> 6);
    { const int t0 = wave_s * 64 + (int)__lane_id(); if (t0 < 4) misc[t0] = 0u; }
    __syncthreads();
    XcdBarrier bar = xcd_barrier_post((unsigned*)(p.ws + WS_CTL + 65536), misc, wave_s * 64 + (int)__lane_id());
    for (int ph = p.ph_lo; ph < p.ph_hi; ++ph) {
      const int nrep = (ph == p.rep_ph) ? p.rep_n : 1;
      for (int rep = 0; rep < nrep; ++rep) {
        int wv_ = wave_s; asm volatile("" : "+s"(wv_)); int lid_; asm volatile("v_mbcnt_lo_u32_b32 %0, -1, 0\n\tv_mbcnt_hi_u32_b32 %0, -1, %0" : "=&v"(lid_)); int tid = wv_ * 64 + lid_;
        int cb = blockIdx.x; asm volatile("" : "+s"(cb));
        int G = gridDim.x; asm volatile("" : "+s"(G));
        size_t wz = 0; asm volatile("" : "+s"(wz)); unsigned char* ws = p.ws + wz;
        const int lane = tid & 63, wid = __builtin_amdgcn_readfirstlane(tid >> 6);
        const int gw = cb * 8 + wid, ngw = G * 8;
        const bf16_t* XN = (const bf16_t*)(ws + WS_XN);
        const float* mod = (const float*)(ws + WS_MOD);
        float* rssb = (float*)(ws + WS_CTL + WS_RSS); const float* swb = (const float*)(ws + WS_SW);
        const bool tailmode = G >= 224;
        unsigned* tailcnt = (unsigned*)(ws + WS_CTL + 57344);
        if (ph == 0) prep_phase(p, ws, lds, tid, wid, lane, cb, G);
        else if (ph == 1) phase1(p, ws, gw, ngw, lane);
        else {
            const int l = (ph - 2) / 7, r = (ph - 2) % 7;
            if (r == 0 || r == 5) {
                const int f = (r == 5) ? 1 : 0, mi = l * 2 + f, ni = l * 3 + (f ? 2 : 0);
                const char* Wg = (const char*)(ws + WS_W + (size_t)mi * FFN_STRIDE);
                pg8::GemmDesc g0{(const char*)XN, Wg, tailmode ? 32 : 48, 22, 0, 0}, g1{(const char*)XN + (size_t)32 * 256 * D * 2, Wg, tailmode ? 16 : 0, tailmode ? 20 : 0, 32, 0};
                pg8::Sched2 S; S.init(g0, g1, D, G, cb);
                EpiGU E{(bf16_t*)(ws + WS_R + R_HID), rssb + ni * MTOK, swb + mi * 3 * 5632};
                pg8::gemm_phase<EpiGU, pg8::Sched2>(lds, tid, D, S, E);
            } else if (r == 1 || r == 6 || r == 4) {
                const char* A; const char* B; int K, jdx, nl, nj; float w;
                if (r == 4) { jdx = 1; w = 1.f; nl = l; nj = 2; if (l == 0) { A = (const char*)(ws + WS_R + R_AO); B = (const char*)(ws + WS_WO); K = 1024; } else { A = (const char*)(ws + WS_R + R_U); B = (const char*)(ws + WS_WSO); K = 2048; } }
                else { const int f = (r == 6) ? 1 : 0, mi = l * 2 + f; jdx = f ? 2 : 0; w = 0.5f; A = (const char*)(ws + WS_R + R_HID); B = (const char*)(ws + WS_W + (size_t)mi * FFN_STRIDE + FFN_DOWN); K = FH;
                       if (f == 0) { nl = l; nj = 1; } else { nl = l + 1; nj = 0; } }
                pg8::GemmDesc g0{A, B, 48, 4, 0, 0}, g1{nullptr, nullptr, 0, 0, 0, 0};
                pg8::Sched2 S; S.init(g0, g1, K, G, cb);
                const int ffn = (r == 4) ? -1 : l * 2 + ((r == 6) ? 1 : 0);
                EpiRes E{p.out, mod, p.in[8], ws, p.in[0], p.in[1], l, 3 * jdx + 2, nl < 2 ? nl * 3 + nj : -1, (tailmode && ffn >= 0) ? tailcnt + ffn * 256 : nullptr};
                pg8::gemm_phase<EpiRes, pg8::Sched2>(lds, tid, K, S, E);
                if (cb >= 192 && G > 192) {
                    int lid2; asm volatile("v_mbcnt_lo_u32_b32 %0, -1, 0\n\tv_mbcnt_hi_u32_b32 %0, -1, %0" : "=&v"(lid2)); int tid2 = wv_ * 64 + lid2;
                    if (tailmode && ffn >= 0 && cb < 224) {
                        const char* Wg = (const char*)(ws + WS_W + (size_t)ffn * FFN_STRIDE);
                        pg8::GemmDesc t0{(const char*)XN + (size_t)32 * 256 * D * 2, Wg + (size_t)20 * 256 * D * 2, 16, 2, 32, 20}, t1{nullptr, nullptr, 0, 0, 0, 0};
                        pg8::Sched2 ST; ST.init(t0, t1, D, 32, cb - 192);
                        EpiGU EG{(bf16_t*)(ws + WS_R + R_HID), rssb + (l * 3 + ((r == 6) ? 2 : 0)) * MTOK, swb + ffn * 3 * 5632};
                        pg8::gemm_phase<EpiGU, pg8::Sched2>(lds, tid2, D, ST, EG);
                        pg8::Unit tu; ST.next(0, tu);
                        asm volatile("s_waitcnt vmcnt(0)" ::: "memory"); __syncthreads();
                        asm volatile("v_mbcnt_lo_u32_b32 %0, -1, 0\n\tv_mbcnt_hi_u32_b32 %0, -1, %0" : "=&v"(lid2)); tid2 = wv_ * 64 + lid2;
                        if (tid2 == 0) { __builtin_amdgcn_fence(__ATOMIC_RELEASE, "agent"); asm volatile("s_waitcnt vmcnt(0)" ::: "memory");
                                        __hip_atomic_fetch_add(tailcnt + ffn * 256 + (tu.pm - 32) * 16, 1u, __ATOMIC_RELAXED, __HIP_MEMORY_SCOPE_AGENT); }
                        __syncthreads();
                    }
                    const int igw = (cb - 192) * 8 + wid, ingw = (G - 192) * 8;
                    if (ph == 3) { conv_caches(p, ws, (cb - 192) * 512 + tid2, (G - 192) * 512); convert_list(p, ws, lds, (1 << 1) | (1 << 5) | (1 << 9), igw, ingw, wid, lid2); }
                    else if (ph == 6) { mod_gemv(p, ws, lds, 1, 2, igw, ingw, tid2, lid2); convert_list(p, ws, lds, (1 << 2), igw, ingw, wid, lid2); sw_rows(p, ws, (1 << 1), igw, ingw, lid2); }
                    else if (ph == 8) { convert_list(p, ws, lds, (1 << 6) | (1 << 10), igw, ingw, wid, lid2); sw_rows(p, ws, (1 << 2), igw, ingw, lid2); }
                    else if (ph == 10) { convert_list(p, ws, lds, (1 << 3) | (1 << 7) | (1 << 11), igw, ingw, wid, lid2); sw_rows(p, ws, (1 << 6), igw, ingw, lid2); }
                    else if (ph == 13) sw_rows(p, ws, (1 << 3), igw, ingw, lid2);
                }
            } else if (r == 2) {
                if (l == 0) {
                    pg8::GemmDesc g0{(const char*)XN, (const char*)(ws + WS_WQK), 48, 7, 0, 0}, g1{(const char*)(ws + WS_WV), (const char*)XN, 3, 48, 0, 0};
                    pg8::Sched2 S; S.init(g0, g1, D, G, cb);
                    unsigned char* R = ws + WS_R;
                    EpiQKV E{(bf16_t*)(R + R_QNA), (bf16_t*)(R + R_VT), p.out, (const float*)(ws + WS_GTAB), rssb + 1 * MTOK, swb + SW_QKV};
                    pg8::gemm_phase<EpiQKV, pg8::Sched2>(lds, tid, D, S, E);
                } else {
                    pg8::GemmDesc g0{(const char*)XN, (const char*)(ws + WS_WSI), 48, 8, 0, 0}, g1{(const char*)(ws + WS_WSI + (size_t)2048 * D * 2), (const char*)XN, 8, 48, 0, 0};
                    pg8::Sched2 S; S.init(g0, g1, D, G, cb);
                    EpiSGU E{(bf16_t*)(ws + WS_R + R_U), (bf16_t*)(ws + WS_R + R_VTS), (float*)(ws + WS_CTL + 4096), rssb + 4 * MTOK, swb + SW_SGU};
                    pg8::gemm_phase<EpiSGU, pg8::Sched2>(lds, tid, D, S, E);
                }
            } else {
                if (l == 0) attn_phase(p, ws, lds, tid, wid, lane, rep); else spatial_phase(p, ws, wid, lane, cb, G);
            }
        }
        if (ph + 1 < p.ph_hi || rep + 1 < nrep) {
            { XcdBarrier b2 = bar; size_t bz = 0; asm volatile("" : "+s"(bz)); b2.bar = bar.bar + bz; xcd_barrier(b2, tid); }
        }
      }
    }
}

extern "C" void kernel_launch(void* const* d_in, const int* in_sizes, int n_in, void* d_out, int out_size, void* d_ws, size_t ws_size, hipStream_t stream) {
    static int grid = 0;
    if (grid == 0) {
        if (n_in != 27 || ws_size < WS_END) { fprintf(stderr, "kernel_launch: unexpected n_in %d / ws_size %zu\n", n_in, ws_size); grid = -1; return; }
        int dev = 0, cus = 0, per_cu = 0;
        (void)hipGetDevice(&dev);
        (void)hipDeviceGetAttribute(&cus, hipDeviceAttributeMultiprocessorCount, dev);
        if (hipFuncSetAttribute((const void*)mega_fwd, hipFuncAttributeMaxDynamicSharedMemorySize, LDS_BYTES) != hipSuccess) { fprintf(stderr, "kernel_launch: hipFuncSetAttribute failed\n"); grid = -1; return; }
        if (hipOccupancyMaxActiveBlocksPerMultiprocessor(&per_cu, (const void*)mega_fwd, 512, LDS_BYTES) != hipSuccess || per_cu < 1) { fprintf(stderr, "kernel_launch: occupancy query says %d\n", per_cu); grid = -1; (void)hipGetLastError(); return; }
        grid = cus;
    }
    if (grid < 0) return;
    (void)hipMemsetAsync((char*)d_ws + WS_CTL, 0, CTL_BYTES, stream);
    Params p{};
    for (int i = 0; i < 27; ++i) p.in[i] = (const float*)d_in[i];
    p.out = (float*)d_out; p.ws = (unsigned char*)d_ws; p.ph_lo = 0; p.ph_hi = 16; p.rep_ph = -1; p.rep_n = 1;
    void* args[] = {&p};
    hipError_t e = hipLaunchCooperativeKernel((const void*)mega_fwd, dim3(grid), dim3(512), args, LDS_BYTES, stream);
    if (e != hipSuccess) fprintf(stderr, "cooperative launch failed: %s (grid %d)\n", hipGetErrorString(e), grid);
}
```

```cpp
#include <hip/hip_runtime.h>
#include <hip/hip_cooperative_groups.h>
#include <cstdio>
#include <cstdint>
namespace cg = cooperative_groups;

#define LAS __attribute__((address_space(3)))
#define DI __device__ __forceinline__
typedef unsigned short bf16_t;
typedef short bf16x8 __attribute__((ext_vector_type(8)));
typedef float f32x4 __attribute__((ext_vector_type(4)));
typedef float f32x2 __attribute__((ext_vector_type(2)));
typedef float f32x16 __attribute__((ext_vector_type(16)));
typedef unsigned u32x4 __attribute__((ext_vector_type(4)));
typedef unsigned u32x2 __attribute__((ext_vector_type(2)));
typedef __bf16 bf16x2_t __attribute__((ext_vector_type(2)));

constexpr int D = 1024, MTOK = 12288, MP = 8192, FH = 2816, NMOD = 9216;
constexpr float LOG2E = 1.4426950408889634f;
constexpr float EPS = 1e-6f;
constexpr size_t O_NAK = 12582912, O_NAV = 16777216, O_GK = 20971520, O_GV = 22020096;
constexpr size_t MiB = 1u << 20;
constexpr size_t WS_CTL = 0, CTL_BYTES = 704 * 1024;
constexpr size_t WS_RSS = 131072;
constexpr size_t WS_SW = 5 * MiB;
constexpr int SW_QKV = 4 * 3 * 5632, SW_SGU = SW_QKV + 3 * 2560;
constexpr size_t WS_GTAB = 768 * 1024;
constexpr size_t WS_MOD = 448 * 1024;
constexpr size_t WS_KCNA = 2 * MiB, WS_VCNAT = 3 * MiB, WS_KCG = 4 * MiB, WS_VCGT = 4 * MiB + 256 * 1024;
constexpr size_t WS_W = 8 * MiB, FFN_STRIDE = 17301504, FFN_DOWN = 11 * MiB;
constexpr size_t WS_WQK = 74 * MiB, WS_WV = WS_WQK + 3670016, WS_WO = 79 * MiB, WS_WSI = 81 * MiB, WS_WSO = 89 * MiB;
constexpr size_t WS_XN = 96 * MiB;
constexpr size_t WS_R = 120 * MiB;
constexpr size_t R_HID = 0;
constexpr size_t R_QNA = 0, R_KNA = 12 * MiB, R_QG = 24 * MiB, R_KG = 36 * MiB, R_VT = 40 * MiB, R_AO = 58 * MiB;
constexpr size_t R_U = 0, R_VTS = 48 * MiB;
constexpr size_t WS_END = 216 * MiB;
constexpr int LDS_BYTES = 135168;

struct Params { const float* in[27]; float* out; unsigned char* ws; int ph_lo, ph_hi, rep_ph, rep_n; };

DI unsigned pk2(float lo, float hi) { f32x2 v = {lo, hi}; bf16x2_t b = __builtin_convertvector(v, bf16x2_t); return __builtin_bit_cast(unsigned, b); }
DI float bf2f(unsigned short b) { return __builtin_bit_cast(float, (unsigned)b << 16); }
template <int CTRL> DI float dppf(float v) { return __builtin_bit_cast(float, __builtin_amdgcn_update_dpp(0, __builtin_bit_cast(int, v), CTRL, 0xf, 0xf, true)); }
DI float row16_sum(float v) { v += dppf<0xB1>(v); v += dppf<0x4E>(v); v += dppf<0x124>(v); v += dppf<0x128>(v); return v; }
DI float xor16_sum(float v) { const unsigned b = __builtin_bit_cast(unsigned, v); auto r = __builtin_amdgcn_permlane16_swap(b, b, false, false); return __builtin_bit_cast(float, (unsigned)r[0]) + __builtin_bit_cast(float, (unsigned)r[1]); }
DI float xor32_sum(float v) { const unsigned b = __builtin_bit_cast(unsigned, v); auto r = __builtin_amdgcn_permlane32_swap(b, b, false, false); return __builtin_bit_cast(float, (unsigned)r[0]) + __builtin_bit_cast(float, (unsigned)r[1]); }
DI float xor32_max(float v) { const unsigned b = __builtin_bit_cast(unsigned, v); auto r = __builtin_amdgcn_permlane32_swap(b, b, false, false); return fmaxf(__builtin_bit_cast(float, (unsigned)r[0]), __builtin_bit_cast(float, (unsigned)r[1])); }
DI float wave_sum(float v) { return xor32_sum(xor16_sum(row16_sum(v))); }
DI float silu_f(float x) { return x * __builtin_amdgcn_rcpf(1.f + __builtin_amdgcn_exp2f(-x * LOG2E)); }
DI f32x2 gelu_pk(f32x2 v) {
    const f32x2 av = __builtin_elementwise_abs(v), d = av * 0.2316418882f + 1.0f;
    f32x2 t; t.x = __builtin_amdgcn_rcpf(d.x); t.y = __builtin_amdgcn_rcpf(d.y);
    f32x2 q = t * 0.5307027145f + (-0.7265760135f); q = q * t + 0.7107068705f; q = q * t + (-0.142248368f); q = q * t + 0.127414796f; q = q * t;
    const f32x2 s = (v * v) * (-0.72134752044f);
    f32x2 e; e.x = __builtin_amdgcn_exp2f(s.x); e.y = __builtin_amdgcn_exp2f(s.y);
    const f32x2 m = v * (q * e), r = v - m;
    f32x2 o; o.x = v.x < 0.f ? m.x : r.x; o.y = v.y < 0.f ? m.y : r.y; return o;
}
DI f32x4 gelu4(f32x4 v) { f32x2 a = gelu_pk((f32x2){v[0], v[1]}), b = gelu_pk((f32x2){v[2], v[3]}); return (f32x4){a.x, a.y, b.x, b.y}; }

namespace pg8 {
constexpr int BM = 256, BK = 64, HALF = 128, HTB = HALF * BK * 2, NXCD = 8, WGM = 8;
DI int lds_byte(int r, int c) { const int st = (r >> 4) * 2 + (c >> 5), rr = r & 15, cc = c & 31, ob = rr * 64 + cc * 2; return st * 1024 + (ob ^ (((ob >> 9) & 1) << 5)); }
DI void stage_rc(int b, int& R, int& C) { const int st = b / 1024, sb = b % 1024, swz = sb ^ (((sb >> 9) & 1) << 5); R = (st >> 1) * 16 + swz / 64; C = (st & 1) * 32 + (swz % 64) / 2; }
DI int perm32(int rho) { const int n = rho >> 4, i = rho & 15; return 8 * (i >> 2) + 4 * n + (i & 3); }

struct Unit { const char* a; const char* b; int pm, pn, kind; };
struct GemmDesc { const char* A; const char* B; int nM, nN, pmoff, pnoff; };
struct Sched2 {
    GemmDesc g0, g1; int nwg0, nwg, G, c; size_t tstep;
    DI void init(const GemmDesc& a, const GemmDesc& b, int K, int G_, int c_) { g0 = a; g1 = b; nwg0 = a.nM * a.nN; nwg = nwg0 + b.nM * b.nN; G = G_; c = c_; tstep = (size_t)BM * K * 2; }
    DI bool next(int i, Unit& u) const {
        const long L = (long)i * G + c; if (L >= nwg) return false;
        int wgid = (int)L;
        if ((G & 7) == 0) { const int q = nwg / NXCD, r = nwg % NXCD, xcd = wgid % NXCD, off = wgid / NXCD; wgid = (xcd < r ? xcd * (q + 1) : r * (q + 1) + (xcd - r) * q) + off; }
        const bool k1 = wgid >= nwg0; if (k1) wgid -= nwg0;
        const int nM = k1 ? g1.nM : g0.nM, nN = k1 ? g1.nN : g0.nN;
        const int nig = WGM * nN, gid = wgid / nig, fm = gid * WGM, gsz = (nM - fm) < WGM ? (nM - fm) : WGM;
        const int lpm = fm + ((wgid % nig) % gsz), lpn = (wgid % nig) / gsz; u.kind = k1 ? 1 : 0;
        u.a = (k1 ? g1.A : g0.A) + (size_t)lpm * tstep; u.b = (k1 ? g1.B : g0.B) + (size_t)lpn * tstep;
        u.pm = lpm + (k1 ? g1.pmoff : g0.pmoff); u.pn = lpn + (k1 ? g1.pnoff : g0.pnoff);
        return true;
    }
};

template <class Epi, class Sched>
DI void gemm_phase(LAS unsigned char* lds, const int tid, const int K, const Sched& S, const Epi& E) {
    const int wid = __builtin_amdgcn_readfirstlane(tid >> 6), lane = tid & 63, wr = wid >> 2, wc = wid & 3, fr = lane & 15, fq = lane >> 4;
    const int nt = K / BK;
    unsigned voffA[2], voffB[2];
#pragma unroll
    for (int i = 0; i < 2; ++i) { int R, C; stage_rc(tid * 16 + i * 8192, R, C); const int Rb = Epi::PERM ? ((R & ~31) + perm32(R & 31)) : R;
        voffA[i] = (unsigned)(R * K + C) * 2u; voffB[i] = (unsigned)(Rb * K + C) * 2u; }
    const size_t kstep = (size_t)(BK * 2);
    const size_t hstep = (size_t)HALF * K * 2;
    const unsigned ldsw = (unsigned)wid * 1024u;
    const int aoff = lds_byte(wr * 64 + fr, fq * 8), boff = lds_byte(wc * 32 + fr, fq * 8);
#define PG8_SA(b, h) (((b) * 2 + (h)) * HTB)
#define PG8_SB(b, h) ((4 + (b) * 2 + (h)) * HTB)
#define PG8_STAGE(bufoff, gbase, voff) do { _Pragma("unroll") for (int _i = 0; _i < 2; ++_i) \
        __builtin_amdgcn_global_load_lds((const unsigned*)((const char*)(gbase) + (voff)[_i]), (LAS unsigned*)(lds + (bufoff) + ldsw + _i * 8192), 16, 0, 0); } while (0)
#define PG8_LDA(dst, b, h) do { _Pragma("unroll") for (int m = 0; m < 4; ++m) _Pragma("unroll") for (int k = 0; k < 2; ++k) dst[m][k] = *(const LAS bf16x8*)(lds + PG8_SA(b, h) + aoff + m * 2048 + k * 1024); } while (0)
#define PG8_LDB(dst, b, h) do { _Pragma("unroll") for (int n = 0; n < 2; ++n) _Pragma("unroll") for (int k = 0; k < 2; ++k) dst[n][k] = *(const LAS bf16x8*)(lds + PG8_SB(b, h) + boff + n * 2048 + k * 1024); } while (0)
#define PG8_MMA(ai, bj, At, Bt) do { __builtin_amdgcn_s_setprio(1); _Pragma("unroll") for (int m = 0; m < 4; ++m) _Pragma("unroll") for (int n = 0; n < 2; ++n) _Pragma("unroll") for (int k = 0; k < 2; ++k) \
        acc[ai][bj][m][n] = __builtin_amdgcn_mfma_f32_16x16x32_bf16(Bt[n][k], At[m][k], acc[ai][bj][m][n], 0, 0, 0); __builtin_amdgcn_s_setprio(0); } while (0)
#define PG8_WAIT_V(n) asm volatile("s_waitcnt vmcnt(" #n ")" ::: "memory")
#define PG8_WAIT_L(n) asm volatile("s_waitcnt lgkmcnt(" #n ")" ::: "memory")
#define PG8_BAR __builtin_amdgcn_s_barrier()
#define PG8_SCHED __builtin_amdgcn_sched_barrier(0)
    Unit cur, nxt; int ui = 0;
    if (!S.next(0, cur)) return;
    f32x4 acc[2][2][4][2];
#pragma unroll
    for (int a = 0; a < 2; ++a)
#pragma unroll
        for (int b = 0; b < 2; ++b)
#pragma unroll
            for (int m = 0; m < 4; ++m)
#pragma unroll
                for (int n = 0; n < 2; ++n) acc[a][b][m][n] = (f32x4){0.f, 0.f, 0.f, 0.f};
    bf16x8 At[4][2], B0[2][2], B1[2][2];
    const char* cA = cur.a; const char* cB = cur.b;
    PG8_STAGE(PG8_SB(0, 0), cB, voffB); PG8_STAGE(PG8_SB(0, 1), cB + hstep, voffB); PG8_STAGE(PG8_SA(0, 0), cA, voffA); PG8_STAGE(PG8_SA(0, 1), cA + hstep, voffA);
    if (wr == 1) PG8_BAR;
    PG8_WAIT_V(2); PG8_BAR;
    PG8_STAGE(PG8_SB(1, 0), cB + kstep, voffB); PG8_STAGE(PG8_SA(1, 0), cA + kstep, voffA); PG8_STAGE(PG8_SB(1, 1), cB + hstep + kstep, voffB);
    PG8_WAIT_V(6); PG8_BAR;
    for (;;) {
        const bool has_next = S.next(ui + 1, nxt);
        const char* nA = has_next ? nxt.a : cA; const char* nB = has_next ? nxt.b : cB;
        for (int t = 0; t < nt; t += 2) {
            if constexpr (Epi::KWAIT) { if (t == nt - 6 && E.need_wait(cur)) E.do_wait(cur, wid); }
            const bool last = (t == nt - 2);
            const char* a1 = cA + (size_t)(t + 1) * kstep;
            const char* a2 = last ? nA : cA + (size_t)(t + 2) * kstep; const char* b2 = last ? nB : cB + (size_t)(t + 2) * kstep;
            const char* a3 = a2 + kstep; const char* b3 = b2 + kstep;
            PG8_LDB(B0, 0, 0); PG8_LDB(B1, 0, 1); PG8_SCHED; PG8_LDA(At, 0, 0); PG8_STAGE(PG8_SA(1, 1), a1 + hstep, voffA);
            PG8_WAIT_V(8); PG8_WAIT_L(0); PG8_BAR; PG8_MMA(0, 0, At, B0); PG8_MMA(0, 1, At, B1); PG8_BAR; PG8_SCHED;
            PG8_LDA(At, 0, 1); PG8_STAGE(PG8_SB(0, 0), b2, voffB); PG8_STAGE(PG8_SB(0, 1), b2 + hstep, voffB); PG8_STAGE(PG8_SA(0, 0), a2, voffA);
            PG8_WAIT_V(8); PG8_WAIT_L(0); PG8_BAR; PG8_MMA(1, 0, At, B0); PG8_MMA(1, 1, At, B1); PG8_BAR; PG8_SCHED;
            PG8_LDB(B0, 1, 0); PG8_LDB(B1, 1, 1); PG8_SCHED; PG8_LDA(At, 1, 0); PG8_STAGE(PG8_SA(0, 1), a2 + hstep, voffA);
            PG8_WAIT_V(8); PG8_WAIT_L(0); PG8_BAR; PG8_MMA(0, 0, At, B0); PG8_MMA(0, 1, At, B1); PG8_BAR; PG8_SCHED;
            PG8_LDA(At, 1, 1); PG8_STAGE(PG8_SB(1, 0), b3, voffB); PG8_STAGE(PG8_SB(1, 1), b3 + hstep, voffB); PG8_STAGE(PG8_SA(1, 0), a3, voffA);
            PG8_WAIT_V(8); PG8_WAIT_L(0); PG8_BAR; PG8_MMA(1, 0, At, B0); PG8_MMA(1, 1, At, B1); PG8_BAR; PG8_SCHED;
        }
        if (wr == 0) PG8_BAR;
        E(acc, cur, wr, wc, fr, fq);
        if (!has_next) break;
#pragma unroll
        for (int a = 0; a < 2; ++a)
#pragma unroll
            for (int b = 0; b < 2; ++b)
#pragma unroll
                for (int m = 0; m < 4; ++m)
#pragma unroll
                    for (int n = 0; n < 2; ++n) acc[a][b][m][n] = (f32x4){0.f, 0.f, 0.f, 0.f};
        cur = nxt; cA = nA; cB = nB; ++ui;
        if (wr == 1) PG8_BAR;
    }
    PG8_WAIT_V(0);
    PG8_BAR;
#undef PG8_SA
#undef PG8_SB
#undef PG8_STAGE
#undef PG8_LDA
#undef PG8_LDB
#undef PG8_MMA
#undef PG8_WAIT_V
#undef PG8_WAIT_L
#undef PG8_BAR
#undef PG8_SCHED
}
}

struct EpiGU {
    static constexpr bool PERM = true, KWAIT = false; bf16_t* H; const float* rss; const float* sw;
    DI void operator()(const f32x4 (&acc)[2][2][4][2], const pg8::Unit& u, int wr, int wc, int fr, int fq) const {
        asm volatile("" : "+v"(fr), "+v"(fq));
        const int row0 = u.pm * 256 + wr * 64 + fr, col0 = u.pn * 128 + wc * 32 + 8 * fq;
        const int cond = u.pm < 32 ? 0 : 1 + ((u.pm - 32) >> 3);
        const float* swp = sw + cond * 5632 + u.pn * 256 + wc * 32 + 8 * fq;
        const f32x4 sg0 = *(const f32x4*)(swp), sg1 = *(const f32x4*)(swp + 4), su0 = *(const f32x4*)(swp + 128), su1 = *(const f32x4*)(swp + 132);
        float rs8[8];
#pragma unroll
        for (int it = 0; it < 8; ++it) rs8[it] = rss[row0 + (it >> 2) * 128 + (it & 3) * 16];
#pragma unroll
        for (int ai = 0; ai < 2; ++ai)
#pragma unroll
            for (int m = 0; m < 4; ++m) {
                const int row = row0 + ai * 128 + m * 16;
                const float rstd = rsqrtf(rs8[ai * 4 + m] * (1.f / D) + EPS);
                bf16_t* rowp = H + (size_t)row * FH + col0;
                const f32x4 g0 = acc[ai][0][m][0] * rstd + sg0, g1 = acc[ai][0][m][1] * rstd + sg1, u0 = acc[ai][1][m][0] * rstd + su0, u1 = acc[ai][1][m][1] * rstd + su1;
                u32x4 w;
                w.x = pk2(silu_f(g0[0]) * u0[0], silu_f(g0[1]) * u0[1]); w.y = pk2(silu_f(g0[2]) * u0[2], silu_f(g0[3]) * u0[3]);
                w.z = pk2(silu_f(g1[0]) * u1[0], silu_f(g1[1]) * u1[1]); w.w = pk2(silu_f(g1[2]) * u1[2], silu_f(g1[3]) * u1[3]);
                *(u32x4*)rowp = w;
                __builtin_amdgcn_sched_barrier(0);
            }
    }
};
struct EpiRes {
    static constexpr bool PERM = false, KWAIT = true; float* out; const float* mod; const float* normg; unsigned char* ws; const float* xp; const float* xs; int l, gidx, ni; unsigned* tcnt;
    DI bool need_wait(const pg8::Unit& u) const { return tcnt != nullptr && u.pm >= 32; }
    DI void do_wait(const pg8::Unit& u, int wid) const {
        if (wid == 0) { unsigned sp = 0; while ((unsigned)__builtin_amdgcn_readfirstlane(__hip_atomic_load(tcnt + (u.pm - 32) * 16, __ATOMIC_RELAXED, __HIP_MEMORY_SCOPE_AGENT)) < 2u) { __builtin_amdgcn_s_sleep(2); if (++sp > (1u << 22)) break; }
            __builtin_amdgcn_fence(__ATOMIC_ACQUIRE, "agent"); asm volatile("s_waitcnt vmcnt(0)" ::: "memory"); }
        asm volatile("" ::: "memory"); __builtin_amdgcn_s_barrier(); asm volatile("" ::: "memory");
    }
    DI void operator()(const f32x4 (&acc)[2][2][4][2], const pg8::Unit& u, int wr, int wc, int fr, int fq) const {
        asm volatile("" : "+v"(fr), "+v"(fq));
        const int cond = u.pm < 32 ? 0 : 1 + ((u.pm - 32) >> 3);
        const float* gate = mod + (size_t)l * 3 * NMOD + (cond * 9 + gidx) * D;
        const float w = gidx == 5 ? 1.f : 0.5f;
        const bool nn = ni >= 0; const int nl = nn ? ni / 3 : 0, nj = nn ? ni - 3 * nl : 0;
        const float* ng = normg + (nn ? ni : 0) * D; const float* nscale = mod + (size_t)nl * 3 * NMOD + (cond * 9 + 3 * nj + 1) * D;
        float* rss = (float*)(ws + WS_CTL + WS_RSS) + (nn ? ni : 0) * MTOK; bf16_t* xn = (bf16_t*)(ws + WS_XN);
        const int col0 = u.pn * 256 + wc * 32 + 4 * fq;
        f32x4 gv[2][2], gs[2][2];
#pragma unroll
        for (int bj = 0; bj < 2; ++bj)
#pragma unroll
            for (int n = 0; n < 2; ++n) { const int c = col0 + bj * 128 + n * 16; gv[bj][n] = *(const f32x4*)(gate + c) * w;
                gs[bj][n] = *(const f32x4*)(ng + c) * (*(const f32x4*)(nscale + c) + 1.f); }
        const int rowb = u.pm * 256 + wr * 64 + fr;
        const float* rb = (l == 0 && gidx == 2) ? (u.pm < 32 ? xp : xs - (size_t)MP * D) : out;
        f32x4 bn[2][2];
#pragma unroll
        for (int bj = 0; bj < 2; ++bj)
#pragma unroll
            for (int n = 0; n < 2; ++n) bn[bj][n] = *(const f32x4*)(rb + (size_t)rowb * D + col0 + bj * 128 + n * 16);
#pragma unroll
        for (int it = 0; it < 8; ++it) {
            const int ai = it >> 2, m = it & 3;
            const int row = rowb + ai * 128 + m * 16;
            float* op = out + (size_t)row * D; float ss = 0.f;
            f32x4 bc[2][2];
#pragma unroll
            for (int bj = 0; bj < 2; ++bj)
#pragma unroll
                for (int n = 0; n < 2; ++n) bc[bj][n] = bn[bj][n];
            if (it < 7) { const int rown = rowb + ((it + 1) >> 2) * 128 + ((it + 1) & 3) * 16;
#pragma unroll
                for (int bj = 0; bj < 2; ++bj)
#pragma unroll
                    for (int n = 0; n < 2; ++n) bn[bj][n] = *(const f32x4*)(rb + (size_t)rown * D + col0 + bj * 128 + n * 16); }
#pragma unroll
            for (int bj = 0; bj < 2; ++bj)
#pragma unroll
                for (int n = 0; n < 2; ++n) { const int c = col0 + bj * 128 + n * 16; const f32x4 o = bc[bj][n] + gv[bj][n] * acc[ai][bj][m][n]; *(f32x4*)(op + c) = o;
                    if (nn) { ss += (o[0] * o[0] + o[1] * o[1]) + (o[2] * o[2] + o[3] * o[3]); const f32x4 y = o * gs[bj][n]; u32x2 pw; pw.x = pk2(y[0], y[1]); pw.y = pk2(y[2], y[3]); *(u32x2*)(xn + (size_t)row * D + c) = pw; } }
            if (nn) { ss = xor32_sum(xor16_sum(ss)); if (fq == 0) atomicAdd(rss + row, ss); }
            __builtin_amdgcn_sched_barrier(0);
        }
    }
};
struct EpiQKV {
    static constexpr bool PERM = false, KWAIT = false;
    bf16_t *qk, *vt; float* out; const float* gtab; const float* rss; const float* sw;
    DI void operator()(const f32x4 (&acc)[2][2][4][2], const pg8::Unit& u, int wr, int wc, int fr, int fq) const {
        asm volatile("" : "+v"(fr), "+v"(fq));
        if (u.kind == 0) {
            const int slot = u.pn * 4 + wc;
            if (slot >= 26) return;
            const int type = slot < 8 ? 0 : slot < 16 ? 1 : slot < 24 ? 2 : 3;
            const int h = slot - (type == 0 ? 0 : type == 1 ? 8 : type == 2 ? 16 : 24);
            const float* g = gtab + type * 64;
            bf16_t* dst = qk + (size_t)slot * MTOK * 64;
            const float qs = (type == 0 || type == 2) ? 0.125f * LOG2E : 1.f;
            const bool rope = (type >= 2) && (u.pm >= 32);
            f32x4 gv[2][2];
#pragma unroll
            for (int bj = 0; bj < 2; ++bj)
#pragma unroll
                for (int n = 0; n < 2; ++n) gv[bj][n] = *(const f32x4*)(g + 32 * bj + 16 * n + 4 * fq);
            const int cond = u.pm < 32 ? 0 : 1 + ((u.pm - 32) >> 3);
            f32x4 sv[2][2];
#pragma unroll
            for (int bj = 0; bj < 2; ++bj)
#pragma unroll
                for (int n = 0; n < 2; ++n) sv[bj][n] = *(const f32x4*)(sw + cond * 2560 + u.pn * 256 + bj * 128 + wc * 32 + 16 * n + 4 * fq);
            float rs8[8];
#pragma unroll
            for (int it = 0; it < 8; ++it) rs8[it] = rss[u.pm * 256 + (it >> 2) * 128 + wr * 64 + (it & 3) * 16 + fr];
            float freq[4];
#pragma unroll
            for (int i = 0; i < 4; ++i) freq[i] = __builtin_amdgcn_exp2f(-(float)(4 * fq + i) * (0.0625f * 13.287712379549449f));
#pragma unroll
            for (int ai = 0; ai < 2; ++ai)
#pragma unroll
                for (int m = 0; m < 4; ++m) {
                    const int row = u.pm * 256 + ai * 128 + wr * 64 + m * 16 + fr;
                    f32x4 y[2][2]; float ss = 0.f; const float rin = rsqrtf(rs8[ai * 4 + m] * (1.f / D) + EPS);
#pragma unroll
                    for (int bj = 0; bj < 2; ++bj)
#pragma unroll
                        for (int n = 0; n < 2; ++n) { y[bj][n] = acc[ai][bj][m][n] * rin + sv[bj][n]; const f32x4 x = y[bj][n]; ss += (x[0] * x[0] + x[1] * x[1]) + (x[2] * x[2] + x[3] * x[3]); }
                    ss = xor32_sum(xor16_sum(ss));
                    const float rstd = rsqrtf(ss * (1.f / 64.f) + EPS);
#pragma unroll
                    for (int bj = 0; bj < 2; ++bj)
#pragma unroll
                        for (int n = 0; n < 2; ++n) y[bj][n] = y[bj][n] * rstd * gv[bj][n];
                    if (rope) {
                        const int t = (row - MP) & 2047;
#pragma unroll
                        for (int bj = 0; bj < 2; ++bj) {
                            const float pos = (float)(bj == 0 ? (t >> 6) : (t & 63));
#pragma unroll
                            for (int i = 0; i < 4; ++i) {
                                const float ang = pos * freq[i]; const float sn = __sinf(ang), cs = __cosf(ang);
                                const float x1 = y[bj][0][i], x2 = y[bj][1][i];
                                y[bj][0][i] = x1 * cs - x2 * sn; y[bj][1][i] = x1 * sn + x2 * cs;
                            }
                        }
                    }
                    if (u.pm < 32 && (type == 1 || type == 3)) {
                        const size_t oo = (type == 1 ? O_NAK + (size_t)row * 512 : O_GK + (size_t)row * 128) + h * 64;
                        float* o = out + oo;
#pragma unroll
                        for (int bj = 0; bj < 2; ++bj)
#pragma unroll
                            for (int n = 0; n < 2; ++n) *(f32x4*)(o + 32 * bj + 16 * n + 4 * fq) = y[bj][n];
                    }
                    bf16_t* dp = dst + (size_t)row * 64 + 4 * fq;
#pragma unroll
                    for (int bj = 0; bj < 2; ++bj)
#pragma unroll
                        for (int n = 0; n < 2; ++n) { const f32x4 v = y[bj][n] * qs; u32x2 w; w.x = pk2(v[0], v[1]); w.y = pk2(v[2], v[3]); *(u32x2*)(dp + 32 * bj + 16 * n) = w; }
                    __builtin_amdgcn_sched_barrier(0);
                }
        } else {
            const int condt = u.pn < 32 ? 0 : 1 + ((u.pn - 32) >> 3);
            f32x4 rt[2][2]; float sw8[8];
#pragma unroll
            for (int bj = 0; bj < 2; ++bj)
#pragma unroll
                for (int n = 0; n < 2; ++n) { const f32x4 q4 = *(const f32x4*)(rss + u.pn * 256 + bj * 128 + wc * 32 + 16 * n + 4 * fq);
#pragma unroll
                    for (int i = 0; i < 4; ++i) rt[bj][n][i] = rsqrtf(q4[i] * (1.f / D) + EPS); }
#pragma unroll
            for (int it = 0; it < 8; ++it) { const int dv = u.pm * 256 + (it >> 2) * 128 + wr * 64 + (it & 3) * 16 + fr; sw8[it] = sw[condt * 2560 + 1792 + (dv < 768 ? dv : 0)]; }
#pragma unroll
            for (int ai = 0; ai < 2; ++ai)
#pragma unroll
                for (int m = 0; m < 4; ++m) {
                    const int dv = u.pm * 256 + ai * 128 + wr * 64 + m * 16 + fr;
                    if (dv < 640) {
                        const float swv = sw8[ai * 4 + m];
#pragma unroll
                        for (int bj = 0; bj < 2; ++bj)
#pragma unroll
                            for (int n = 0; n < 2; ++n) {
                                const int tok0 = u.pn * 256 + bj * 128 + wc * 32 + 16 * n + 4 * fq;
                                const f32x4 v = acc[ai][bj][m][n] * rt[bj][n] + swv;
                                u32x2 w; w.x = pk2(v[0], v[1]); w.y = pk2(v[2], v[3]);
                                *(u32x2*)(vt + (size_t)dv * MTOK + tok0) = w;
                                if (u.pn < 32) {
                                    if (dv < 512) { float* o = out + O_NAV + (size_t)tok0 * 512 + dv; o[0] = v[0]; o[512] = v[1]; o[1024] = v[2]; o[1536] = v[3]; }
                                    else { float* o = out + O_GV + (size_t)tok0 * 128 + (dv - 512); o[0] = v[0]; o[128] = v[1]; o[256] = v[2]; o[384] = v[3]; }
                                }
                            }
                    }
                    __builtin_amdgcn_sched_barrier(0);
                }
        }
    }
};
struct EpiSGU {
    static constexpr bool PERM = true, KWAIT = false; bf16_t* U; bf16_t* VTS; float* rowss; const float* rss; const float* sw;
    DI void operator()(const f32x4 (&acc)[2][2][4][2], const pg8::Unit& u, int wr, int wc, int fr, int fq) const {
        asm volatile("" : "+v"(fr), "+v"(fq));
        const int r0 = u.pm * 256 + wr * 64 + fr, c0 = u.pn * 256 + wc * 32 + 8 * fq;
        bf16_t* base = u.kind ? VTS : U; const size_t ld = u.kind ? (size_t)MTOK : (size_t)2048;
        const int condc = u.kind ? (u.pn < 32 ? 0 : 1 + ((u.pn - 32) >> 3)) : (u.pm < 32 ? 0 : 1 + ((u.pm - 32) >> 3));
        f32x4 cs[2][2];
#pragma unroll
        for (int bj = 0; bj < 2; ++bj)
#pragma unroll
            for (int n = 0; n < 2; ++n) {
                if (u.kind == 0) cs[bj][n] = *(const f32x4*)(sw + condc * 4096 + c0 + bj * 128 + 4 * n);
                else { const f32x4 q4 = *(const f32x4*)(rss + c0 + bj * 128 + 4 * n);
#pragma unroll
                    for (int i = 0; i < 4; ++i) cs[bj][n][i] = rsqrtf(q4[i] * (1.f / D) + EPS); }
            }
        f32x4 sq[2][2];
#pragma unroll
        for (int bj = 0; bj < 2; ++bj)
#pragma unroll
            for (int n = 0; n < 2; ++n) sq[bj][n] = (f32x4){0.f, 0.f, 0.f, 0.f};
        float rs8[8];
#pragma unroll
        for (int it = 0; it < 8; ++it) { const int row = r0 + (it >> 2) * 128 + (it & 3) * 16; rs8[it] = u.kind ? sw[condc * 4096 + 2048 + row] : rss[row]; }
#pragma unroll
        for (int ai = 0; ai < 2; ++ai)
#pragma unroll
            for (int m = 0; m < 4; ++m) {
                const int row = r0 + ai * 128 + m * 16;
                const float rsc = u.kind ? rs8[ai * 4 + m] : rsqrtf(rs8[ai * 4 + m] * (1.f / D) + EPS);
                bf16_t* rowp = base + (size_t)row * ld + c0;
#pragma unroll
                for (int bj = 0; bj < 2; ++bj) {
                    const f32x4 x0 = u.kind ? acc[ai][bj][m][0] * cs[bj][0] + rsc : acc[ai][bj][m][0] * rsc + cs[bj][0];
                    const f32x4 x1 = u.kind ? acc[ai][bj][m][1] * cs[bj][1] + rsc : acc[ai][bj][m][1] * rsc + cs[bj][1];
                    const f32x4 a = gelu4(x0), b = gelu4(x1);
                    sq[bj][0] += a * a; sq[bj][1] += b * b;
                    u32x4 w; w.x = pk2(a[0], a[1]); w.y = pk2(a[2], a[3]); w.z = pk2(b[0], b[1]); w.w = pk2(b[2], b[3]); *(u32x4*)(rowp + bj * 128) = w; }
                __builtin_amdgcn_sched_barrier(0);
            }
        if (u.kind) {
#pragma unroll
            for (int bj = 0; bj < 2; ++bj)
#pragma unroll
                for (int n = 0; n < 2; ++n)
#pragma unroll
                    for (int i = 0; i < 4; ++i) {
                        float s = sq[bj][n][i];
                        s = row16_sum(s);
                        if (fr == 0) atomicAdd(rowss + c0 + bj * 128 + 4 * n + i, s);
                    }
        }
    }
};

struct TItem { const float* src; bf16_t* dst0; bf16_t* dst1; int ldw, Kd; };
DI void titem_load(const TItem& t, int lane, float (&v)[64]) {
#pragma unroll
    for (int i = 0; i < 64; ++i) v[i] = t.src[(size_t)i * t.ldw + lane];
}
DI void titem_finish(const TItem& t, LAS float* scr, int lane, const float (&v)[64]) {
#pragma unroll
    for (int i = 0; i < 64; ++i) scr[i * 65 + lane] = v[i];
    asm volatile("s_waitcnt lgkmcnt(0)" ::: "memory");
    const int c = lane & 7;
#pragma unroll
    for (int j = 0; j < 8; ++j) { const int n = (lane >> 3) + 8 * j; const LAS float* s = scr + (8 * c) * 65 + n;
        u32x4 o; o.x = pk2(s[0 * 65], s[1 * 65]); o.y = pk2(s[2 * 65], s[3 * 65]); o.z = pk2(s[4 * 65], s[5 * 65]); o.w = pk2(s[6 * 65], s[7 * 65]);
        bf16_t* d = (j < 4 ? t.dst0 + (size_t)n * t.Kd : t.dst1 + (size_t)(n - 32) * t.Kd) + 8 * c;
        *(u32x4*)d = o; }
    asm volatile("s_waitcnt lgkmcnt(0)" ::: "memory");
}
DI void convert_list(const Params& p, unsigned char* ws, LAS unsigned char* lds, int mask, int gw, int ngw, int wid, int lane) {
    LAS float* scr = (LAS float*)(lds + wid * 16640);
    int NIT = 0;
#pragma unroll
    for (int m = 0; m < 12; ++m) { const int cnt = m < 4 ? 1408 : m < 8 ? 704 : m == 8 ? 576 : m == 9 ? 256 : m == 10 ? 1024 : 512; if ((mask >> m) & 1) NIT += cnt; }
    auto decode = [&](int a, TItem& t) {
        int mm = 0, r = a; bool found = false;
#pragma unroll
        for (int m = 0; m < 12; ++m) { const int cnt = m < 4 ? 1408 : m < 8 ? 704 : m == 8 ? 576 : m == 9 ? 256 : m == 10 ? 1024 : 512;
            if (!found && ((mask >> m) & 1)) { if (r < cnt) { mm = m; found = true; } else r -= cnt; } }
        const float* W; bf16_t* WT; int ldw, Kd, k0, n0, drow0, drow1;
        if (mm < 4) { const int mi = mm, l = mi >> 1, f = mi & 1;
            W = (f ? p.in[13] : p.in[11]) + (size_t)l * D * 5632; const int kb = r / 88, nb = r % 88; n0 = nb * 64; k0 = kb * 64; ldw = 5632; Kd = D;
            drow0 = n0 < FH ? (n0 >> 7) * 256 + (n0 & 127) : ((n0 - FH) >> 7) * 256 + 128 + ((n0 - FH) & 127); drow1 = drow0 + 32;
            WT = (bf16_t*)(ws + WS_W + (size_t)mi * FFN_STRIDE); }
        else if (mm < 8) { const int mi = mm - 4, l = mi >> 1, f = mi & 1;
            W = (f ? p.in[14] : p.in[12]) + (size_t)l * FH * D; const int kb = r / 16, nb = r % 16; n0 = nb * 64; k0 = kb * 64; ldw = D; Kd = FH; drow0 = n0; drow1 = n0 + 32;
            WT = (bf16_t*)(ws + WS_W + (size_t)mi * FFN_STRIDE + FFN_DOWN); }
        else if (mm == 8) { const int kb = r / 36, slot = r % 36; n0 = slot * 64; k0 = kb * 64; ldw = 2304; Kd = D; W = p.in[15];
            if (slot >= 16 && slot < 24) { WT = (bf16_t*)(ws + WS_WV); drow0 = (slot - 16) * 64; drow1 = drow0 + 32; }
            else if (slot >= 34) { WT = (bf16_t*)(ws + WS_WV); drow0 = 512 + (slot - 34) * 64; drow1 = drow0 + 32; }
            else { const int q = slot < 16 ? slot : slot - 8; WT = (bf16_t*)(ws + WS_WQK); drow0 = (q >> 2) * 256 + 32 * (q & 3); drow1 = drow0 + 128; } }
        else if (mm == 9) { const int kb = r / 16, nb = r % 16; n0 = nb * 64; k0 = kb * 64; ldw = D; Kd = D; W = p.in[16]; WT = (bf16_t*)(ws + WS_WO); drow0 = n0; drow1 = n0 + 32; }
        else if (mm == 10) { const int kb = r / 64, nb = r % 64; n0 = nb * 64; k0 = kb * 64; ldw = 4096; Kd = D; W = p.in[22]; WT = (bf16_t*)(ws + WS_WSI); drow0 = n0; drow1 = n0 + 32; }
        else { const int kb = r / 16, nb = r % 16; n0 = nb * 64; k0 = kb * 64; ldw = D; Kd = 2048; W = p.in[26]; WT = (bf16_t*)(ws + WS_WSO); drow0 = n0; drow1 = n0 + 32; }
        t.src = W + (size_t)k0 * ldw + n0; t.dst0 = WT + (size_t)drow0 * Kd + k0; t.dst1 = WT + (size_t)drow1 * Kd + k0; t.ldw = ldw; t.Kd = Kd;
    };
    for (int it = gw; it < NIT; it += ngw) { TItem cur; float vc[64]; decode(it, cur); titem_load(cur, lane, vc); titem_finish(cur, scr, lane, vc); }
}
DI void mod_gemv(const Params& p, unsigned char* ws, LAS unsigned char* lds, int l_lo, int l_hi, int gw, int ngw, int tid, int lane) {
    LAS float* silu = (LAS float*)lds;
    for (int i = tid; i < 3072; i += 512) { const int ci = i >> 10, k = i & 1023; const float x = ci == 0 ? p.in[7][k] : p.in[6][(ci - 1) * D + k]; silu[i] = x / (1.f + __expf(-x)); }
    __syncthreads();
    float* mod = (float*)(ws + WS_MOD);
    const int ntask = (l_hi - l_lo) * 4608;
    for (int id = gw; id < ntask; id += ngw) {
        const int l = l_lo + id / 4608, r = id % 4608, kc = r / 144, st = r - kc * 144, n0 = st * 64, k0 = kc * 32;
        const float* w = p.in[9] + (size_t)l * D * NMOD + (size_t)k0 * NMOD + n0 + lane;
        float wv[32];
#pragma unroll
        for (int kk = 0; kk < 32; ++kk) wv[kk] = w[(size_t)kk * NMOD];
        float a0 = 0.f, a1 = 0.f, a2 = 0.f;
#pragma unroll
        for (int kk = 0; kk < 32; ++kk) { a0 += silu[k0 + kk] * wv[kk]; a1 += silu[1024 + k0 + kk] * wv[kk]; a2 += silu[2048 + k0 + kk] * wv[kk]; }
        if (kc == 0) { const float bb = p.in[10][l * NMOD + n0 + lane]; a0 += bb; a1 += bb; a2 += bb; }
        atomicAdd(mod + (size_t)(l * 3 + 0) * NMOD + n0 + lane, a0); atomicAdd(mod + (size_t)(l * 3 + 1) * NMOD + n0 + lane, a1); atomicAdd(mod + (size_t)(l * 3 + 2) * NMOD + n0 + lane, a2);
    }
    __syncthreads();
}
DI void conv_caches(const Params& p, unsigned char* ws, int gt, int nth) {
    bf16_t* kcna = (bf16_t*)(ws + WS_KCNA); bf16_t* vcnat = (bf16_t*)(ws + WS_VCNAT); bf16_t* kcg = (bf16_t*)(ws + WS_KCG); bf16_t* vcgt = (bf16_t*)(ws + WS_VCGT);
    for (int i = gt; i < 524288; i += nth) {
        { const int d = i & 63, l = (i >> 6) & 511, h = (i >> 15) & 7, b = i >> 18; kcna[i] = (bf16_t)pk2(p.in[2][((size_t)(b * 512 + l) * 8 + h) * 64 + d], 0.f); }
        { const int l = i & 511, d = (i >> 9) & 63, h = (i >> 15) & 7, b = i >> 18; vcnat[i] = (bf16_t)pk2(p.in[3][((size_t)(b * 512 + l) * 8 + h) * 64 + d], 0.f); }
    }
    for (int i = gt; i < 131072; i += nth) {
        { const int d = i & 63, l = (i >> 6) & 511, kv = (i >> 15) & 1, b = i >> 16; kcg[i] = (bf16_t)pk2(p.in[4][((size_t)(b * 512 + l) * 2 + kv) * 64 + d], 0.f); }
        { const int l = i & 511, d = (i >> 9) & 63, kv = (i >> 15) & 1, b = i >> 16; vcgt[i] = (bf16_t)pk2(p.in[5][((size_t)(b * 512 + l) * 2 + kv) * 64 + d], 0.f); }
    }
}
DI void prep_phase(const Params& p, unsigned char* ws, LAS unsigned char* lds, int tid, int wid, int lane, int cb, int G) {
    mod_gemv(p, ws, lds, 0, G > 192 ? 1 : 2, cb * 8 + wid, G * 8, tid, lane);
    {
        const int gt = cb * 512 + tid, nth = G * 512;
        if (G <= 192) conv_caches(p, ws, gt, nth);
        unsigned* z0a = (unsigned*)(ws + WS_WQK + (size_t)1600 * D * 2); unsigned* z0b = (unsigned*)(ws + WS_WQK + (size_t)1728 * D * 2); unsigned* z1 = (unsigned*)(ws + WS_WV + (size_t)640 * D * 2);
        for (int i = gt; i < 65536; i += nth) { if (i < 32768) z0a[i] = 0u; else z0b[i - 32768] = 0u; z1[i] = 0u; }
        if (gt < 256) { const int ty = gt >> 6, d = gt & 63; ((float*)(ws + WS_GTAB))[gt] = ty == 0 ? p.in[17][d] : ty == 1 ? p.in[18][d] : ty == 2 ? p.in[20][d] : p.in[21][d]; }
    }
    convert_list(p, ws, lds, G > 192 ? 0x111 : 0xfff, cb * 8 + wid, G * 8, wid, lane);
}

DI void sw_rows(const Params& p, unsigned char* ws, int sel, int gw, int ngw, int lane) {
    float* swb = (float*)(ws + WS_SW); const float* mod = (const float*)(ws + WS_MOD);
#pragma unroll 1
    for (int ci = 0; ci < 7; ++ci) {
        if (!((sel >> ci) & 1)) continue;
        const bf16_t* W; int l, j, nrows, cstride; float* o;
        if (ci < 4) { W = (const bf16_t*)(ws + WS_W + (size_t)ci * FFN_STRIDE); l = ci >> 1; j = (ci & 1) ? 2 : 0; o = swb + ci * 3 * 5632; cstride = 5632; nrows = 5632; }
        else if (ci == 4) { W = (const bf16_t*)(ws + WS_WQK); l = 0; j = 1; o = swb + SW_QKV; cstride = 2560; nrows = 1792; }
        else if (ci == 5) { W = (const bf16_t*)(ws + WS_WV); l = 0; j = 1; o = swb + SW_QKV + 1792; cstride = 2560; nrows = 768; }
        else { W = (const bf16_t*)(ws + WS_WSI); l = 1; j = 1; o = swb + SW_SGU; cstride = 4096; nrows = 4096; }
        f32x4 sh[3][4];
#pragma unroll
        for (int c = 0; c < 3; ++c)
#pragma unroll
            for (int q = 0; q < 4; ++q) sh[c][q] = *(const f32x4*)(mod + (size_t)(l * 3 + c) * NMOD + 3 * j * D + lane * 16 + 4 * q);
        for (int row = gw; row < nrows; row += ngw) {
            const u32x4 w0 = *(const u32x4*)(W + (size_t)row * D + lane * 16), w1 = *(const u32x4*)(W + (size_t)row * D + lane * 16 + 8);
            float wf[16];
#pragma unroll
            for (int i = 0; i < 4; ++i) { wf[2 * i] = __builtin_bit_cast(float, w0[i] << 16); wf[2 * i + 1] = __builtin_bit_cast(float, w0[i] & 0xffff0000u);
                                          wf[8 + 2 * i] = __builtin_bit_cast(float, w1[i] << 16); wf[8 + 2 * i + 1] = __builtin_bit_cast(float, w1[i] & 0xffff0000u); }
            float a3[3];
#pragma unroll
            for (int c = 0; c < 3; ++c) { float a = 0.f;
#pragma unroll
                for (int q = 0; q < 4; ++q) a += (wf[4 * q] * sh[c][q][0] + wf[4 * q + 1] * sh[c][q][1]) + (wf[4 * q + 2] * sh[c][q][2] + wf[4 * q + 3] * sh[c][q][3]);
                a3[c] = wave_sum(a); }
            if (lane < 3) o[lane * cstride + row] = lane == 0 ? a3[0] : lane == 1 ? a3[1] : a3[2];
        }
    }
}

DI void phase1(const Params& p, unsigned char* ws, int gw, int ngw, int lane) {
    const float* mod = (const float*)(ws + WS_MOD);
    {
        const float* g = p.in[8];
        bf16_t* xn = (bf16_t*)(ws + WS_XN); float* rss0 = (float*)(ws + WS_CTL + WS_RSS);
        for (int m = gw; m < MTOK; m += ngw) {
            const int cond = m < MP ? 0 : 1 + ((m - MP) >> 11);
            const float* row = m < MP ? p.in[0] + (size_t)m * D : p.in[1] + (size_t)(m - MP) * D;
            const float* sc = mod + (cond * 9 + 1) * D;
            f32x4 v[4]; float ss = 0.f;
#pragma unroll
            for (int jj = 0; jj < 4; ++jj) { v[jj] = *(const f32x4*)(row + 4 * lane + 256 * jj); ss += (v[jj][0] * v[jj][0] + v[jj][1] * v[jj][1]) + (v[jj][2] * v[jj][2] + v[jj][3] * v[jj][3]); }
            ss = wave_sum(ss);
            if (lane == 0) rss0[m] = ss;
#pragma unroll
            for (int jj = 0; jj < 4; ++jj) { const int col = 4 * lane + 256 * jj;
                const f32x4 gg = *(const f32x4*)(g + col), s1 = *(const f32x4*)(sc + col);
                const f32x4 y = v[jj] * gg * (s1 + 1.f);
                u32x2 w; w.x = pk2(y[0], y[1]); w.y = pk2(y[2], y[3]); *(u32x2*)(xn + (size_t)m * D + col) = w; }
        }
    }
    sw_rows(p, ws, ngw > 1536 ? 0x31 : 0x7f, gw, ngw, lane);
}

#define MFMA32(a, b, c) __builtin_amdgcn_mfma_f32_32x32x16_bf16((a), (b), (c), 0, 0, 0)
constexpr int AT_ROW = 144;
constexpr int AT_KBUF = 0, AT_VBUF = 2 * 64 * AT_ROW, AT_RPB = 4 * 64 * AT_ROW, AT_TASK = AT_RPB + 2048;
struct ATask { const bf16_t* k0; const bf16_t* vt0; const bf16_t* kc; const bf16_t* vtc; int type, nsteps, urow0; };
DI void at_src(const ATask& T, int u, const bf16_t*& k, const bf16_t*& vt, int& vld) {
    if (T.type == 0) { k = T.k0 + (size_t)u * 4096; vt = T.vt0 + u * 64; vld = MTOK; }
    else if (T.type == 1) { if (u < 32) { k = T.k0 + (size_t)u * 4096; vt = T.vt0 + u * 64; vld = MTOK; } else { k = T.kc + (size_t)(u - 32) * 4096; vt = T.vtc + (u - 32) * 64; vld = 512; } }
    else { if (u < 8) { k = T.kc + (size_t)u * 4096; vt = T.vtc + u * 64; vld = 512; } else { const int tok = (T.urow0 + (u - 8)) * 64; k = T.k0 + (size_t)tok * 64; vt = T.vt0 + tok; vld = MTOK; } }
}
DI void at_gload(const ATask& T, int u, int tid, u32x4& a, u32x4& b) {
    const bf16_t* k; const bf16_t* vt; int vld; at_src(T, u, k, vt, vld);
    if (tid < 256) { const bf16_t* p = k + (tid >> 3) * 64 + (tid & 7) * 8; a = *(const u32x4*)p; b = *(const u32x4*)(p + 32 * 64); }
    else { const int j = tid - 256; const bf16_t* p = vt + (size_t)(j >> 2) * vld + (j & 3) * 8; a = *(const u32x4*)p; b = *(const u32x4*)(p + 32); }
}
DI void at_lstore(LAS unsigned char* lds, int buf, int tid, u32x4 a, u32x4 b) {
    if (tid < 256) { LAS unsigned char* p = lds + AT_KBUF + buf * 64 * AT_ROW + (tid >> 3) * AT_ROW + (tid & 7) * 16; *(LAS u32x4*)p = a; *(LAS u32x4*)(p + 32 * AT_ROW) = b; }
    else { const int j = tid - 256, c = j & 3, s = c >> 1, sec = c & 1; LAS unsigned char* row = lds + AT_VBUF + buf * 64 * AT_ROW + (j >> 2) * AT_ROW;
        const int o0 = ((s * 2 + 0) * 2 + sec) * 8, o1 = ((s * 2 + 1) * 2 + sec) * 8;
        *(LAS u32x2*)(row + o0) = (u32x2){a.x, a.y}; *(LAS u32x2*)(row + o1) = (u32x2){a.z, a.w};
        *(LAS u32x2*)(row + 64 + o0) = (u32x2){b.x, b.y}; *(LAS u32x2*)(row + 64 + o1) = (u32x2){b.z, b.w}; }
}
DI void attn_phase(const Params& p, unsigned char* ws, LAS unsigned char* lds, int tid, int wid, int lane, int rep) {
    unsigned char* R = ws + WS_R;
    const bf16_t* QNA = (const bf16_t*)(R + R_QNA); const bf16_t* KNA = (const bf16_t*)(R + R_KNA); const bf16_t* QG = (const bf16_t*)(R + R_QG); const bf16_t* KG = (const bf16_t*)(R + R_KG);
    const bf16_t* VT = (const bf16_t*)(R + R_VT); bf16_t* AO = (bf16_t*)(R + R_AO);
    const bf16_t* KCNA = (const bf16_t*)(ws + WS_KCNA); const bf16_t* VCNAT = (const bf16_t*)(ws + WS_VCNAT); const bf16_t* KCG = (const bf16_t*)(ws + WS_KCG); const bf16_t* VCGT = (const bf16_t*)(ws + WS_VCGT);
    unsigned* counter = (unsigned*)(ws + WS_CTL) + 64 * rep;
    LAS float* rpb_l = (LAS float*)(lds + AT_RPB); volatile LAS int* taskw = (volatile LAS int*)(lds + AT_TASK);
    const int r32 = lane & 31, hi = lane >> 5;
    for (;;) {
        if (tid == 0) taskw[0] = (int)atomicAdd(counter, 1u);
        __syncthreads();
        const int t = __builtin_amdgcn_readfirstlane(taskw[0]);
        if (t >= 768) break;
        ATask T; T.kc = nullptr; T.vtc = nullptr; T.urow0 = 0;
        const bf16_t* q; bf16_t* o; int r = 0, cblk = 0, row0 = 0;
        if (t < 128) {
            const int b = t >> 6, kv = (t >> 5) & 1, grp = t & 31, qh = kv * 4 + (grp >> 3), qb = (grp & 7) * 8 + wid, tok0 = MP + b * 2048;
            q = QG + ((size_t)qh * MTOK + tok0 + qb * 32) * 64; T.k0 = KG + ((size_t)kv * MTOK + tok0) * 64; T.vt0 = VT + (size_t)(512 + kv * 64) * MTOK + tok0;
            T.kc = KCG + (size_t)((b * 2 + kv) * 512) * 64; T.vtc = VCGT + (size_t)((b * 2 + kv) * 64) * 512; o = AO + (size_t)(tok0 + qb * 32) * D + 512 + qh * 64; T.type = 1; T.nsteps = 40;
        } else if (t < 256) {
            const int i = t - 128, b = i >> 6, h = (i >> 3) & 7, rg = i & 7, tok0 = MP + b * 2048;
            r = 4 * rg + (wid >> 1); cblk = wid & 1; row0 = min(max(r - 4, 0), 24);
            T.urow0 = min(max(4 * rg - 4, 0), 24); const int urow1 = min(max(4 * rg - 1, 0), 24) + 7;
            const int qb = r * 2 + cblk;
            q = QNA + ((size_t)h * MTOK + tok0 + qb * 32) * 64; T.k0 = KNA + ((size_t)h * MTOK + tok0) * 64; T.vt0 = VT + (size_t)(h * 64) * MTOK + tok0;
            T.kc = KCNA + (size_t)((b * 8 + h) * 512) * 64; T.vtc = VCNAT + (size_t)((b * 8 + h) * 64) * 512; o = AO + (size_t)(tok0 + qb * 32) * D + h * 64; T.type = 2; T.nsteps = 8 + (urow1 - T.urow0 + 1);
            if (tid < 465) rpb_l[tid] = p.in[19][h * 465 + tid] * LOG2E;
        } else {
            const int i = t - 256, isB = i >> 8, j = i & 255, b = j >> 3, h = j & 7, tok0 = b * 256, qb = wid;
            if (!isB) { q = QNA + ((size_t)h * MTOK + tok0 + qb * 32) * 64; T.k0 = KNA + ((size_t)h * MTOK + tok0) * 64; T.vt0 = VT + (size_t)(h * 64) * MTOK + tok0; o = AO + (size_t)(tok0 + qb * 32) * D + h * 64; }
            else { const int kv = h >> 2; q = QG + ((size_t)h * MTOK + tok0 + qb * 32) * 64; T.k0 = KG + ((size_t)kv * MTOK + tok0) * 64; T.vt0 = VT + (size_t)(512 + kv * 64) * MTOK + tok0; o = AO + (size_t)(tok0 + qb * 32) * D + 512 + h * 64; }
            T.type = 0; T.nsteps = 4;
        }
        const int ns = T.nsteps;
        u32x4 pa, pb, pc, pd; at_gload(T, 0, tid, pc, pd); at_gload(T, 1, tid, pa, pb);
        bf16x8 qf[4];
#pragma unroll
        for (int ks = 0; ks < 4; ++ks) qf[ks] = *(const bf16x8*)(q + r32 * 64 + ks * 16 + hi * 8);
        at_lstore(lds, 0, tid, pc, pd);
        float mrun = -1e30f, lrun = 0.f; f32x16 o0, o1;
#pragma unroll
        for (int i = 0; i < 16; ++i) { o0[i] = 0.f; o1[i] = 0.f; }
        __syncthreads();
        for (int u = 0; u < ns; ++u) {
            if (u + 1 < ns) at_lstore(lds, (u + 1) & 1, tid, pa, pb);
            if (u + 2 < ns) at_gload(T, u + 2, tid, pa, pb);
            bool active = true; const bool local = (T.type == 2 && u >= 8); int kr = 0;
            if (local) { kr = T.urow0 + (u - 8); active = (kr >= row0) && (kr < row0 + 8); }
            if (active) {
                const LAS unsigned char* kb = lds + AT_KBUF + (u & 1) * 64 * AT_ROW + r32 * AT_ROW + hi * 16;
                const LAS unsigned char* vb = lds + AT_VBUF + (u & 1) * 64 * AT_ROW + r32 * AT_ROW + hi * 16;
                f32x16 st[2];
#pragma unroll
                for (int h2 = 0; h2 < 2; ++h2) {
                    bf16x8 kf[4];
#pragma unroll
                    for (int ks = 0; ks < 4; ++ks) kf[ks] = *(const LAS bf16x8*)(kb + h2 * 32 * AT_ROW + ks * 32);
#pragma unroll
                    for (int i = 0; i < 16; ++i) st[h2][i] = 0.f;
#pragma unroll
                    for (int ks = 0; ks < 4; ++ks) st[h2] = MFMA32(kf[ks], qf[ks], st[h2]);
                }
                if (local) {
                    const int dr = kr - r + 7; const int qc = 32 * cblk + r32; const int wsq = min(max(qc - 8, 0), 48);
#pragma unroll
                    for (int h2 = 0; h2 < 2; ++h2) {
                        const int base = dr * 31 + 15 - qc + 32 * h2 + 4 * hi;
#pragma unroll
                        for (int i = 0; i < 16; ++i) { const int ko = (i & 3) + 8 * (i >> 2); const int kc = 32 * h2 + 4 * hi + ko; const bool ok = (kc >= wsq) && (kc < wsq + 16);
                            const float bias = rpb_l[ok ? base + ko : 0]; st[h2][i] = ok ? st[h2][i] + bias : -1e30f; }
                    }
                }
                float mx = fmaxf(fmaxf(st[0][0], st[0][1]), fmaxf(st[1][0], st[1][1]));
#pragma unroll
                for (int i = 2; i < 16; i += 2) mx = fmaxf(mx, fmaxf(fmaxf(st[0][i], st[0][i + 1]), fmaxf(st[1][i], st[1][i + 1])));
                mx = xor32_max(mx);
                if (__any(mx > mrun)) {
                    const float mnew = fmaxf(mrun, mx), alpha = __builtin_amdgcn_exp2f(mrun - mnew); mrun = mnew;
                    lrun *= alpha;
#pragma unroll
                    for (int i = 0; i < 16; ++i) { o0[i] *= alpha; o1[i] *= alpha; }
                }
                float ps0 = 0.f, ps1 = 0.f;
#pragma unroll
                for (int i = 0; i < 16; ++i) { st[0][i] = __builtin_amdgcn_exp2f(st[0][i] - mrun); ps0 += st[0][i]; st[1][i] = __builtin_amdgcn_exp2f(st[1][i] - mrun); ps1 += st[1][i]; }
                lrun += ps0 + ps1;
#pragma unroll
                for (int h2 = 0; h2 < 2; ++h2) {
                    u32x4 p0, p1;
                    p0.x = pk2(st[h2][0], st[h2][1]); p0.y = pk2(st[h2][2], st[h2][3]); p0.z = pk2(st[h2][4], st[h2][5]); p0.w = pk2(st[h2][6], st[h2][7]);
                    p1.x = pk2(st[h2][8], st[h2][9]); p1.y = pk2(st[h2][10], st[h2][11]); p1.z = pk2(st[h2][12], st[h2][13]); p1.w = pk2(st[h2][14], st[h2][15]);
                    const bf16x8 pf0 = __builtin_bit_cast(bf16x8, p0), pf1 = __builtin_bit_cast(bf16x8, p1);
                    bf16x8 vf[4];
#pragma unroll
                    for (int db = 0; db < 2; ++db)
#pragma unroll
                        for (int s = 0; s < 2; ++s) vf[db * 2 + s] = *(const LAS bf16x8*)(vb + db * 32 * AT_ROW + h2 * 64 + s * 32);
                    o0 = MFMA32(vf[0], pf0, o0); o0 = MFMA32(vf[1], pf1, o0);
                    o1 = MFMA32(vf[2], pf0, o1); o1 = MFMA32(vf[3], pf1, o1);
                }
            }
            __syncthreads();
        }
        lrun = xor32_sum(lrun);
        const float inv = 1.f / lrun;
        bf16_t* op = o + (size_t)r32 * D + 4 * hi;
#pragma unroll
        for (int gq = 0; gq < 4; ++gq) {
            u32x2 w0, w1;
            w0.x = pk2(o0[4 * gq] * inv, o0[4 * gq + 1] * inv); w0.y = pk2(o0[4 * gq + 2] * inv, o0[4 * gq + 3] * inv);
            w1.x = pk2(o1[4 * gq] * inv, o1[4 * gq + 1] * inv); w1.y = pk2(o1[4 * gq + 2] * inv, o1[4 * gq + 3] * inv);
            *(u32x2*)(op + 8 * gq) = w0; *(u32x2*)(op + 32 + 8 * gq) = w1;
        }
    }
}

DI void spatial_phase(const Params& p, unsigned char* ws, LAS unsigned char* lds, int tid, int wid, int lane, int cb, int G) {
    unsigned char* R = ws + WS_R;
    bf16_t* U = (bf16_t*)(R + R_U); const bf16_t* VTS = (const bf16_t*)(R + R_VTS);
    const float* rowss = (const float*)(ws + WS_CTL + 4096);
    const float* Ws = p.in[24]; const float* bs = p.in[25]; const float* vg = p.in[23];
    const int r32 = lane & 31, hi = lane >> 5, tb = wid & 3, dh = wid >> 2;
    for (int unit = cb; unit < 768; unit += G) {
        const int c = unit >> 3, g = unit & 7;
        const int t = 128 * c + 32 * tb + r32;
        u32x4 stg[8];
#pragma unroll
        for (int j = 0; j < 8; ++j) stg[j] = *(const u32x4*)(VTS + (size_t)(256 * g + (tid >> 4) + 32 * j) * MTOK + 128 * c + (tid & 15) * 8);
        u32x2 uu[4][4];
#pragma unroll
        for (int db = 0; db < 4; ++db)
#pragma unroll
            for (int gq = 0; gq < 4; ++gq) uu[db][gq] = *(const u32x2*)(U + (size_t)t * 2048 + 256 * g + 128 * dh + 32 * db + 8 * gq + 4 * hi);
        __syncthreads();
#pragma unroll
        for (int j = 0; j < 8; ++j) *(LAS u32x4*)(lds + ((tid >> 4) + 32 * j) * 272 + (tid & 15) * 16) = stg[j];
        __syncthreads();
        bf16x8 bfr[8];
        const float* wsr = Ws + ((size_t)g * 128 + 32 * tb + r32) * 128;
#pragma unroll
        for (int ks = 0; ks < 8; ++ks) { const int s0 = 16 * ks + 8 * hi;
            const f32x4 w0 = *(const f32x4*)(wsr + s0), w1 = *(const f32x4*)(wsr + s0 + 4);
            const f32x4 q0 = *(const f32x4*)(rowss + 128 * c + s0), q1 = *(const f32x4*)(rowss + 128 * c + s0 + 4);
            f32x4 r0, r1;
#pragma unroll
            for (int i = 0; i < 4; ++i) { r0[i] = rsqrtf(q0[i] * (1.f / 2048.f) + EPS); r1[i] = rsqrtf(q1[i] * (1.f / 2048.f) + EPS); }
            u32x4 w; w.x = pk2(w0[0] * r0[0], w0[1] * r0[1]); w.y = pk2(w0[2] * r0[2], w0[3] * r0[3]); w.z = pk2(w1[0] * r1[0], w1[1] * r1[1]); w.w = pk2(w1[2] * r1[2], w1[3] * r1[3]);
            bfr[ks] = __builtin_bit_cast(bf16x8, w); }
        const float bias = bs[g * 128 + 32 * tb + r32];
#pragma unroll
        for (int db = 0; db < 4; ++db) {
            f32x4 vg4[4];
#pragma unroll
            for (int gq = 0; gq < 4; ++gq) vg4[gq] = *(const f32x4*)(vg + 256 * g + 128 * dh + 32 * db + 8 * gq + 4 * hi);
            f32x16 acc;
#pragma unroll
            for (int i = 0; i < 16; ++i) acc[i] = 0.f;
#pragma unroll
            for (int ks = 0; ks < 8; ++ks) { const bf16x8 a = *(const LAS bf16x8*)(lds + (128 * dh + 32 * db + r32) * 272 + (16 * ks + 8 * hi) * 2); acc = MFMA32(a, bfr[ks], acc); }
#pragma unroll
            for (int gq = 0; gq < 4; ++gq) { const int d = 256 * g + 128 * dh + 32 * db + 8 * gq + 4 * hi;
                bf16_t* up = U + (size_t)t * 2048 + d; const u32x2 u2 = uu[db][gq];
                const float u0 = bf2f((unsigned short)(u2.x & 0xffffu)), u1 = bf2f((unsigned short)(u2.x >> 16)), u2f = bf2f((unsigned short)(u2.y & 0xffffu)), u3 = bf2f((unsigned short)(u2.y >> 16));
                u32x2 w; w.x = pk2(u0 * (acc[4 * gq] * vg4[gq][0] + bias), u1 * (acc[4 * gq + 1] * vg4[gq][1] + bias)); w.y = pk2(u2f * (acc[4 * gq + 2] * vg4[gq][2] + bias), u3 * (acc[4 * gq + 3] * vg4[gq][3] + bias));
                *(u32x2*)up = w; }
        }
    }
}

#define XB_TMO      128
#define XB_XCNT(j)  (256  + 64 * (j))
#define XB_XSUB(j)  (1280 + 64 * (j))
#define XB_XGEN(j)  (2304 + 64 * (j))
#define XB_TOP      3328
#define XB_TOPGEN   3392
#define XCD_BAR_WORDS 3456
#define XB_SPIN_CAP (1u << 18)
DI unsigned xb_ld(unsigned* p)              { return __hip_atomic_load(p, __ATOMIC_RELAXED, __HIP_MEMORY_SCOPE_AGENT); }
DI unsigned xb_add(unsigned* p, unsigned v) { return __hip_atomic_fetch_add(p, v, __ATOMIC_RELAXED, __HIP_MEMORY_SCOPE_AGENT); }
DI unsigned xb_xcc_id() { return (unsigned)__builtin_amdgcn_s_getreg((3 << 11) | 20) & 0xFu; }
#define XB_SPIN(cond, bar) do { unsigned _sp = 0; while (cond) { __builtin_amdgcn_s_sleep(1); \
    if ((++_sp & 255u) == 0u) { if (xb_ld(&(bar)[XB_TMO])) break; if (_sp > XB_SPIN_CAP) { atomicAdd(&(bar)[XB_TMO], 1u); break; } } } } while (0)
struct XcdBarrier { unsigned* bar; unsigned x; volatile LAS unsigned* st; };
DI XcdBarrier xcd_barrier_post(unsigned* bar, volatile LAS unsigned* st, int tid) {
    XcdBarrier b; b.bar = bar; b.x = xb_xcc_id(); b.st = st;
    if (tid == 0) (void)xb_add(&bar[XB_XCNT(b.x)], 1u);
    return b;
}
DI void xcd_barrier_complete(unsigned* bar, unsigned x, unsigned& nloc, unsigned& nx) {
    const unsigned G = gridDim.x * gridDim.y * gridDim.z;
    unsigned sum, cnt, mine, sp = 0u;
    for (;;) {
        sum = 0u; cnt = 0u; mine = 0u;
#pragma unroll
        for (unsigned j = 0; j < 16; ++j) { const unsigned c = xb_ld(&bar[XB_XCNT(j)]); sum += c; cnt += (c > 0u) ? 1u : 0u; mine = (j == x) ? c : mine; }
        if (sum == G) break;
        __builtin_amdgcn_s_sleep(1);
        if ((++sp & 255u) == 0u) { if (xb_ld(&bar[XB_TMO])) break; if (sp > XB_SPIN_CAP) { atomicAdd(&bar[XB_TMO], 1u); break; } }
    }
    nloc = mine > 0u ? mine : 1u; nx = cnt > 0u ? cnt : 1u;
}
DI void xcd_barrier(const XcdBarrier& b, int tid) {
    asm volatile("s_waitcnt vmcnt(0)" ::: "memory");
    __syncthreads();
    if (tid == 0) {
        unsigned* bar = b.bar;
        __builtin_amdgcn_s_waitcnt(0);
        unsigned nloc = b.st[0], nx = b.st[1];
        if (nloc == 0u) { xcd_barrier_complete(bar, b.x, nloc, nx); b.st[0] = nloc; b.st[1] = nx; }
        const unsigned old = xb_add(&bar[XB_XSUB(b.x)], 1u);
        const unsigned gen = old / nloc;
        if (old + 1u == (gen + 1u) * nloc) {
            __builtin_amdgcn_fence(__ATOMIC_RELEASE, "agent");
            asm volatile("s_waitcnt vmcnt(0)" ::: "memory");
            const unsigned og = xb_add(&bar[XB_TOP], 1u);
            const unsigned tg = og / nx;
            if (og + 1u == (tg + 1u) * nx) xb_add(&bar[XB_TOPGEN], 1u);
            else XB_SPIN(xb_ld(&bar[XB_TOPGEN]) == tg, bar);
            __builtin_amdgcn_fence(__ATOMIC_ACQUIRE, "agent");
            xb_add(&bar[XB_XGEN(b.x)], 1u);
            asm volatile("s_waitcnt vmcnt(0)" ::: "memory");
        } else {
            XB_SPIN(xb_ld(&bar[XB_XGEN(b.x)]) == gen, bar);
            __builtin_amdgcn_fence(__ATOMIC_ACQUIRE, "agent");
            asm volatile("s_waitcnt vmcnt(0)" ::: "memory");
        }
    }
    __syncthreads();
}

__global__ void __launch_bounds__(512, 2) mega_fwd(Params p) {
    extern __shared__ __attribute__((aligned(16))) unsigned char lds_raw[];
    LAS unsigned char* lds = (LAS unsigned char*)lds_raw;
    volatile LAS unsigned* misc = (volatile LAS unsigned*)(lds + LDS_BYTES - 64);
    const int wave_s = __builtin_amdgcn_readfirstlane((int)threadIdx.x >> 6);
    { const int t0 = wave_s * 64 + (int)__lane_id(); if (t0 < 4) misc[t0] = 0u; }
    __syncthreads();
    XcdBarrier bar = xcd_barrier_post((unsigned*)(p.ws + WS_CTL + 65536), misc, wave_s * 64 + (int)__lane_id());
    for (int ph = p.ph_lo; ph < p.ph_hi; ++ph) {
      const int nrep = (ph == p.rep_ph) ? p.rep_n : 1;
      for (int rep = 0; rep < nrep; ++rep) {
        int wv_ = wave_s; asm volatile("" : "+s"(wv_)); int lid_; asm volatile("v_mbcnt_lo_u32_b32 %0, -1, 0\n\tv_mbcnt_hi_u32_b32 %0, -1, %0" : "=&v"(lid_)); int tid = wv_ * 64 + lid_;
        int cb = blockIdx.x; asm volatile("" : "+s"(cb));
        int G = gridDim.x; asm volatile("" : "+s"(G));
        size_t wz = 0; asm volatile("" : "+s"(wz)); unsigned char* ws = p.ws + wz;
        const int lane = tid & 63, wid = __builtin_amdgcn_readfirstlane(tid >> 6);
        const int gw = cb * 8 + wid, ngw = G * 8;
        const bf16_t* XN = (const bf16_t*)(ws + WS_XN);
        const float* mod = (const float*)(ws + WS_MOD);
        float* rssb = (float*)(ws + WS_CTL + WS_RSS); const float* swb = (const float*)(ws + WS_SW);
        const bool tailmode = G >= 224;
        unsigned* tailcnt = (unsigned*)(ws + WS_CTL + 57344);
        if (ph == 0) prep_phase(p, ws, lds, tid, wid, lane, cb, G);
        else if (ph == 1) phase1(p, ws, gw, ngw, lane);
        else {
            const int l = (ph - 2) / 7, r = (ph - 2) % 7;
            if (r == 0 || r == 5) {
                const int f = (r == 5) ? 1 : 0, mi = l * 2 + f, ni = l * 3 + (f ? 2 : 0);
                const char* Wg = (const char*)(ws + WS_W + (size_t)mi * FFN_STRIDE);
                pg8::GemmDesc g0{(const char*)XN, Wg, tailmode ? 32 : 48, 22, 0, 0}, g1{(const char*)XN + (size_t)32 * 256 * D * 2, Wg, tailmode ? 16 : 0, tailmode ? 20 : 0, 32, 0};
                pg8::Sched2 S; S.init(g0, g1, D, G, cb);
                EpiGU E{(bf16_t*)(ws + WS_R + R_HID), rssb + ni * MTOK, swb + mi * 3 * 5632};
                pg8::gemm_phase<EpiGU, pg8::Sched2>(lds, tid, D, S, E);
            } else if (r == 1 || r == 6 || r == 4) {
                const char* A; const char* B; int K, jdx, nl, nj; float w;
                if (r == 4) { jdx = 1; w = 1.f; nl = l; nj = 2; if (l == 0) { A = (const char*)(ws + WS_R + R_AO); B = (const char*)(ws + WS_WO); K = 1024; } else { A = (const char*)(ws + WS_R + R_U); B = (const char*)(ws + WS_WSO); K = 2048; } }
                else { const int f = (r == 6) ? 1 : 0, mi = l * 2 + f; jdx = f ? 2 : 0; w = 0.5f; A = (const char*)(ws + WS_R + R_HID); B = (const char*)(ws + WS_W + (size_t)mi * FFN_STRIDE + FFN_DOWN); K = FH;
                       if (f == 0) { nl = l; nj = 1; } else { nl = l + 1; nj = 0; } }
                pg8::GemmDesc g0{A, B, 48, 4, 0, 0}, g1{nullptr, nullptr, 0, 0, 0, 0};
                pg8::Sched2 S; S.init(g0, g1, K, G, cb);
                const int ffn = (r == 4) ? -1 : l * 2 + ((r == 6) ? 1 : 0);
                EpiRes E{p.out, mod, p.in[8], ws, p.in[0], p.in[1], l, 3 * jdx + 2, nl < 2 ? nl * 3 + nj : -1, (tailmode && ffn >= 0) ? tailcnt + ffn * 256 : nullptr};
                pg8::gemm_phase<EpiRes, pg8::Sched2>(lds, tid, K, S, E);
                if (cb >= 192 && G > 192) {
                    int lid2; asm volatile("v_mbcnt_lo_u32_b32 %0, -1, 0\n\tv_mbcnt_hi_u32_b32 %0, -1, %0" : "=&v"(lid2)); int tid2 = wv_ * 64 + lid2;
                    if (tailmode && ffn >= 0 && cb < 224) {
                        const char* Wg = (const char*)(ws + WS_W + (size_t)ffn * FFN_STRIDE);
                        pg8::GemmDesc t0{(const char*)XN + (size_t)32 * 256 * D * 2, Wg + (size_t)20 * 256 * D * 2, 16, 2, 32, 20}, t1{nullptr, nullptr, 0, 0, 0, 0};
                        pg8::Sched2 ST; ST.init(t0, t1, D, 32, cb - 192);
                        EpiGU EG{(bf16_t*)(ws + WS_R + R_HID), rssb + (l * 3 + ((r == 6) ? 2 : 0)) * MTOK, swb + ffn * 3 * 5632};
                        pg8::gemm_phase<EpiGU, pg8::Sched2>(lds, tid2, D, ST, EG);
                        pg8::Unit tu; ST.next(0, tu);
                        asm volatile("s_waitcnt vmcnt(0)" ::: "memory"); __syncthreads();
                        asm volatile("v_mbcnt_lo_u32_b32 %0, -1, 0\n\tv_mbcnt_hi_u32_b32 %0, -1, %0" : "=&v"(lid2)); tid2 = wv_ * 64 + lid2;
                        if (tid2 == 0) { __builtin_amdgcn_fence(__ATOMIC_RELEASE, "agent"); asm volatile("s_waitcnt vmcnt(0)" ::: "memory");
                                        __hip_atomic_fetch_add(tailcnt + ffn * 256 + (tu.pm - 32) * 16, 1u, __ATOMIC_RELAXED, __HIP_MEMORY_SCOPE_AGENT); }
                        __syncthreads();
                    }
                    const int igw = (cb - 192) * 8 + wid, ingw = (G - 192) * 8;
                    if (ph == 3) { conv_caches(p, ws, (cb - 192) * 512 + tid2, (G - 192) * 512); convert_list(p, ws, lds, (1 << 1) | (1 << 5) | (1 << 9), igw, ingw, wid, lid2); }
                    else if (ph == 6) { mod_gemv(p, ws, lds, 1, 2, igw, ingw, tid2, lid2); convert_list(p, ws, lds, (1 << 2), igw, ingw, wid, lid2); sw_rows(p, ws, (1 << 1), igw, ingw, lid2); }
                    else if (ph == 8) { convert_list(p, ws, lds, (1 << 6) | (1 << 10), igw, ingw, wid, lid2); sw_rows(p, ws, (1 << 2), igw, ingw, lid2); }
                    else if (ph == 10) { convert_list(p, ws, lds, (1 << 3) | (1 << 7) | (1 << 11), igw, ingw, wid, lid2); sw_rows(p, ws, (1 << 6), igw, ingw, lid2); }
                    else if (ph == 13) sw_rows(p, ws, (1 << 3), igw, ingw, lid2);
                }
            } else if (r == 2) {
                if (l == 0) {
                    pg8::GemmDesc g0{(const char*)XN, (const char*)(ws + WS_WQK), 48, 7, 0, 0}, g1{(const char*)(ws + WS_WV), (const char*)XN, 3, 48, 0, 0};
                    pg8::Sched2 S; S.init(g0, g1, D, G, cb);
                    unsigned char* R = ws + WS_R;
                    EpiQKV E{(bf16_t*)(R + R_QNA), (bf16_t*)(R + R_VT), p.out, (const float*)(ws + WS_GTAB), rssb + 1 * MTOK, swb + SW_QKV};
                    pg8::gemm_phase<EpiQKV, pg8::Sched2>(lds, tid, D, S, E);
                } else {
                    pg8::GemmDesc g0{(const char*)XN, (const char*)(ws + WS_WSI), 48, 8, 0, 0}, g1{(const char*)(ws + WS_WSI + (size_t)2048 * D * 2), (const char*)XN, 8, 48, 0, 0};
                    pg8::Sched2 S; S.init(g0, g1, D, G, cb);
                    EpiSGU E{(bf16_t*)(ws + WS_R + R_U), (bf16_t*)(ws + WS_R + R_VTS), (float*)(ws + WS_CTL + 4096), rssb + 4 * MTOK, swb + SW_SGU};
                    pg8::gemm_phase<EpiSGU, pg8::Sched2>(lds, tid, D, S, E);
                }
            } else {
                if (l == 0) attn_phase(p, ws, lds, tid, wid, lane, rep); else spatial_phase(p, ws, lds, tid, wid, lane, cb, G);
            }
        }
        if (ph + 1 < p.ph_hi || rep + 1 < nrep) {
            { XcdBarrier b2 = bar; size_t bz = 0; asm volatile("" : "+s"(bz)); b2.bar = bar.bar + bz; xcd_barrier(b2, tid); }
        }
      }
    }
}

extern "C" void kernel_launch(void* const* d_in, const int* in_sizes, int n_in, void* d_out, int out_size, void* d_ws, size_t ws_size, hipStream_t stream) {
    static int grid = 0;
    if (grid == 0) {
        if (n_in != 27 || ws_size < WS_END) { fprintf(stderr, "kernel_launch: unexpected n_in %d / ws_size %zu\n", n_in, ws_size); grid = -1; return; }
        int dev = 0, cus = 0, per_cu = 0;
        (void)hipGetDevice(&dev);
        (void)hipDeviceGetAttribute(&cus, hipDeviceAttributeMultiprocessorCount, dev);
        if (hipFuncSetAttribute((const void*)mega_fwd, hipFuncAttributeMaxDynamicSharedMemorySize, LDS_BYTES) != hipSuccess) { fprintf(stderr, "kernel_launch: hipFuncSetAttribute failed\n"); grid = -1; return; }
        if (hipOccupancyMaxActiveBlocksPerMultiprocessor(&per_cu, (const void*)mega_fwd, 512, LDS_BYTES) != hipSuccess || per_cu < 1) { fprintf(stderr, "kernel_launch: occupancy query says %d\n", per_cu); grid = -1; (void)hipGetLastError(); return; }
        grid = cus;
    }
    if (grid < 0) return;
    (void)hipMemsetAsync((char*)d_ws + WS_CTL, 0, CTL_BYTES, stream);
    Params p{};
    for (int i = 0; i < 27; ++i) p.in[i] = (const float*)d_in[i];
    p.out = (float*)d_out; p.ws = (unsigned char*)d_ws; p.ph_lo = 0; p.ph_hi = 16; p.rep_ph = -1; p.rep_n = 1;
    void* args[] = {&p};
    hipError_t e = hipLaunchCooperativeKernel((const void*)mega_fwd, dim3(grid), dim3(512), args, LDS_BYTES, stream);
    if (e != hipSuccess) fprintf(stderr, "cooperative launch failed: %s (grid %d)\n", hipGetErrorString(e), grid);
}
```

```cpp
#include <hip/hip_runtime.h>
#include <hip/hip_cooperative_groups.h>
#include <cstdio>
#include <cstdint>
namespace cg = cooperative_groups;

#define LAS __attribute__((address_space(3)))
#define DI __device__ __forceinline__
typedef unsigned short bf16_t;
typedef short bf16x8 __attribute__((ext_vector_type(8)));
typedef float f32x4 __attribute__((ext_vector_type(4)));
typedef float f32x2 __attribute__((ext_vector_type(2)));
typedef float f32x16 __attribute__((ext_vector_type(16)));
typedef unsigned u32x4 __attribute__((ext_vector_type(4)));
typedef unsigned u32x2 __attribute__((ext_vector_type(2)));
typedef __bf16 bf16x2_t __attribute__((ext_vector_type(2)));

constexpr int D = 1024, MTOK = 12288, MP = 8192, FH = 2816, NMOD = 9216;
constexpr float LOG2E = 1.4426950408889634f;
constexpr float EPS = 1e-6f;
constexpr size_t O_NAK = 12582912, O_NAV = 16777216, O_GK = 20971520, O_GV = 22020096;
constexpr size_t MiB = 1u << 20;
constexpr size_t WS_CTL = 0, CTL_BYTES = 704 * 1024;
constexpr size_t WS_RSS = 131072;
constexpr size_t WS_SW = 5 * MiB;
constexpr int SW_QKV = 4 * 3 * 5632, SW_SGU = SW_QKV + 3 * 2560;
constexpr size_t WS_GTAB = 768 * 1024;
constexpr size_t WS_MOD = 448 * 1024;
constexpr size_t WS_KCNA = 2 * MiB, WS_VCNAT = 3 * MiB, WS_KCG = 4 * MiB, WS_VCGT = 4 * MiB + 256 * 1024;
constexpr size_t WS_W = 8 * MiB, FFN_STRIDE = 17301504, FFN_DOWN = 11 * MiB;
constexpr size_t WS_WQK = 74 * MiB, WS_WV = WS_WQK + 3670016, WS_WO = 79 * MiB, WS_WSI = 81 * MiB, WS_WSO = 89 * MiB;
constexpr size_t WS_XN = 96 * MiB;
constexpr size_t WS_R = 120 * MiB;
constexpr size_t R_HID = 0;
constexpr size_t R_QNA = 0, R_KNA = 12 * MiB, R_QG = 24 * MiB, R_KG = 36 * MiB, R_VT = 40 * MiB, R_AO = 58 * MiB;
constexpr size_t R_U = 0, R_VTS = 48 * MiB;
constexpr size_t WS_END = 216 * MiB;
constexpr int LDS_BYTES = 135168;

struct Params { const float* in[27]; float* out; unsigned char* ws; int ph_lo, ph_hi, rep_ph, rep_n; };

DI unsigned pk2(float lo, float hi) { f32x2 v = {lo, hi}; bf16x2_t b = __builtin_convertvector(v, bf16x2_t); return __builtin_bit_cast(unsigned, b); }
DI float bf2f(unsigned short b) { return __builtin_bit_cast(float, (unsigned)b << 16); }
template <int CTRL> DI float dppf(float v) { return __builtin_bit_cast(float, __builtin_amdgcn_update_dpp(0, __builtin_bit_cast(int, v), CTRL, 0xf, 0xf, true)); }
DI float row16_sum(float v) { v += dppf<0xB1>(v); v += dppf<0x4E>(v); v += dppf<0x124>(v); v += dppf<0x128>(v); return v; }
DI float xor16_sum(float v) { const unsigned b = __builtin_bit_cast(unsigned, v); auto r = __builtin_amdgcn_permlane16_swap(b, b, false, false); return __builtin_bit_cast(float, (unsigned)r[0]) + __builtin_bit_cast(float, (unsigned)r[1]); }
DI float xor32_sum(float v) { const unsigned b = __builtin_bit_cast(unsigned, v); auto r = __builtin_amdgcn_permlane32_swap(b, b, false, false); return __builtin_bit_cast(float, (unsigned)r[0]) + __builtin_bit_cast(float, (unsigned)r[1]); }
DI float xor32_max(float v) { const unsigned b = __builtin_bit_cast(unsigned, v); auto r = __builtin_amdgcn_permlane32_swap(b, b, false, false); return fmaxf(__builtin_bit_cast(float, (unsigned)r[0]), __builtin_bit_cast(float, (unsigned)r[1])); }
DI float wave_sum(float v) { return xor32_sum(xor16_sum(row16_sum(v))); }
DI float silu_f(float x) { return x * __builtin_amdgcn_rcpf(1.f + __builtin_amdgcn_exp2f(-x * LOG2E)); }
DI f32x2 gelu_pk(f32x2 v) {
    const f32x2 av = __builtin_elementwise_abs(v), d = av * 0.2316418882f + 1.0f;
    f32x2 t; t.x = __builtin_amdgcn_rcpf(d.x); t.y = __builtin_amdgcn_rcpf(d.y);
    f32x2 q = t * 0.5307027145f + (-0.7265760135f); q = q * t + 0.7107068705f; q = q * t + (-0.142248368f); q = q * t + 0.127414796f; q = q * t;
    const f32x2 s = (v * v) * (-0.72134752044f);
    f32x2 e; e.x = __builtin_amdgcn_exp2f(s.x); e.y = __builtin_amdgcn_exp2f(s.y);
    const f32x2 m = v * (q * e), r = v - m;
    f32x2 o; o.x = v.x < 0.f ? m.x : r.x; o.y = v.y < 0.f ? m.y : r.y; return o;
}
DI f32x4 gelu4(f32x4 v) { f32x2 a = gelu_pk((f32x2){v[0], v[1]}), b = gelu_pk((f32x2){v[2], v[3]}); return (f32x4){a.x, a.y, b.x, b.y}; }

namespace pg8 {
constexpr int BM = 256, BK = 64, HALF = 128, HTB = HALF * BK * 2, NXCD = 8, WGM = 8;
DI int lds_byte(int r, int c) { const int st = (r >> 4) * 2 + (c >> 5), rr = r & 15, cc = c & 31, ob = rr * 64 + cc * 2; return st * 1024 + (ob ^ (((ob >> 9) & 1) << 5)); }
DI void stage_rc(int b, int& R, int& C) { const int st = b / 1024, sb = b % 1024, swz = sb ^ (((sb >> 9) & 1) << 5); R = (st >> 1) * 16 + swz / 64; C = (st & 1) * 32 + (swz % 64) / 2; }
DI int perm32(int rho) { const int n = rho >> 4, i = rho & 15; return 8 * (i >> 2) + 4 * n + (i & 3); }

struct Unit { const char* a; const char* b; int pm, pn, kind; };
struct GemmDesc { const char* A; const char* B; int nM, nN, pmoff, pnoff; };
struct Sched2 {
    GemmDesc g0, g1; int nwg0, nwg, G, c; size_t tstep;
    DI void init(const GemmDesc& a, const GemmDesc& b, int K, int G_, int c_) { g0 = a; g1 = b; nwg0 = a.nM * a.nN; nwg = nwg0 + b.nM * b.nN; G = G_; c = c_; tstep = (size_t)BM * K * 2; }
    DI bool next(int i, Unit& u) const {
        const long L = (long)i * G + c; if (L >= nwg) return false;
        int wgid = (int)L;
        if ((G & 7) == 0) { const int q = nwg / NXCD, r = nwg % NXCD, xcd = wgid % NXCD, off = wgid / NXCD; wgid = (xcd < r ? xcd * (q + 1) : r * (q + 1) + (xcd - r) * q) + off; }
        const bool k1 = wgid >= nwg0; if (k1) wgid -= nwg0;
        const int nM = k1 ? g1.nM : g0.nM, nN = k1 ? g1.nN : g0.nN;
        const int nig = WGM * nN, gid = wgid / nig, fm = gid * WGM, gsz = (nM - fm) < WGM ? (nM - fm) : WGM;
        const int lpm = fm + ((wgid % nig) % gsz), lpn = (wgid % nig) / gsz; u.kind = k1 ? 1 : 0;
        u.a = (k1 ? g1.A : g0.A) + (size_t)lpm * tstep; u.b = (k1 ? g1.B : g0.B) + (size_t)lpn * tstep;
        u.pm = lpm + (k1 ? g1.pmoff : g0.pmoff); u.pn = lpn + (k1 ? g1.pnoff : g0.pnoff);
        return true;
    }
};

template <class Epi, class Sched>
DI void gemm_phase(LAS unsigned char* lds, const int tid, const int K, const Sched& S, const Epi& E) {
    const int wid = __builtin_amdgcn_readfirstlane(tid >> 6), lane = tid & 63, wr = wid >> 2, wc = wid & 3, fr = lane & 15, fq = lane >> 4;
    const int nt = K / BK;
    unsigned voffA[2], voffB[2];
#pragma unroll
    for (int i = 0; i < 2; ++i) { int R, C; stage_rc(tid * 16 + i * 8192, R, C); const int Rb = Epi::PERM ? ((R & ~31) + perm32(R & 31)) : R;
        voffA[i] = (unsigned)(R * K + C) * 2u; voffB[i] = (unsigned)(Rb * K + C) * 2u; }
    const size_t kstep = (size_t)(BK * 2);
    const size_t hstep = (size_t)HALF * K * 2;
    const unsigned ldsw = (unsigned)wid * 1024u;
    const int aoff = lds_byte(wr * 64 + fr, fq * 8), boff = lds_byte(wc * 32 + fr, fq * 8);
#define PG8_SA(b, h) (((b) * 2 + (h)) * HTB)
#define PG8_SB(b, h) ((4 + (b) * 2 + (h)) * HTB)
#define PG8_STAGE(bufoff, gbase, voff) do { _Pragma("unroll") for (int _i = 0; _i < 2; ++_i) \
        __builtin_amdgcn_global_load_lds((const unsigned*)((const char*)(gbase) + (voff)[_i]), (LAS unsigned*)(lds + (bufoff) + ldsw + _i * 8192), 16, 0, 0); } while (0)
#define PG8_LDA(dst, b, h) do { _Pragma("unroll") for (int m = 0; m < 4; ++m) _Pragma("unroll") for (int k = 0; k < 2; ++k) dst[m][k] = *(const LAS bf16x8*)(lds + PG8_SA(b, h) + aoff + m * 2048 + k * 1024); } while (0)
#define PG8_LDB(dst, b, h) do { _Pragma("unroll") for (int n = 0; n < 2; ++n) _Pragma("unroll") for (int k = 0; k < 2; ++k) dst[n][k] = *(const LAS bf16x8*)(lds + PG8_SB(b, h) + boff + n * 2048 + k * 1024); } while (0)
#define PG8_MMA(ai, bj, At, Bt) do { __builtin_amdgcn_s_setprio(1); _Pragma("unroll") for (int m = 0; m < 4; ++m) _Pragma("unroll") for (int n = 0; n < 2; ++n) _Pragma("unroll") for (int k = 0; k < 2; ++k) \
        acc[ai][bj][m][n] = __builtin_amdgcn_mfma_f32_16x16x32_bf16(Bt[n][k], At[m][k], acc[ai][bj][m][n], 0, 0, 0); __builtin_amdgcn_s_setprio(0); } while (0)
#define PG8_WAIT_V(n) asm volatile("s_waitcnt vmcnt(" #n ")" ::: "memory")
#define PG8_WAIT_L(n) asm volatile("s_waitcnt lgkmcnt(" #n ")" ::: "memory")
#define PG8_BAR __builtin_amdgcn_s_barrier()
#define PG8_SCHED __builtin_amdgcn_sched_barrier(0)
    Unit cur, nxt; int ui = 0;
    if (!S.next(0, cur)) return;
    f32x4 acc[2][2][4][2];
#pragma unroll
    for (int a = 0; a < 2; ++a)
#pragma unroll
        for (int b = 0; b < 2; ++b)
#pragma unroll
            for (int m = 0; m < 4; ++m)
#pragma unroll
                for (int n = 0; n < 2; ++n) acc[a][b][m][n] = (f32x4){0.f, 0.f, 0.f, 0.f};
    bf16x8 At[4][2], B0[2][2], B1[2][2];
    const char* cA = cur.a; const char* cB = cur.b;
    PG8_STAGE(PG8_SB(0, 0), cB, voffB); PG8_STAGE(PG8_SB(0, 1), cB + hstep, voffB); PG8_STAGE(PG8_SA(0, 0), cA, voffA); PG8_STAGE(PG8_SA(0, 1), cA + hstep, voffA);
    if (wr == 1) PG8_BAR;
    PG8_WAIT_V(2); PG8_BAR;
    PG8_STAGE(PG8_SB(1, 0), cB + kstep, voffB); PG8_STAGE(PG8_SA(1, 0), cA + kstep, voffA); PG8_STAGE(PG8_SB(1, 1), cB + hstep + kstep, voffB);
    PG8_WAIT_V(6); PG8_BAR;
    for (;;) {
        const bool has_next = S.next(ui + 1, nxt);
        const char* nA = has_next ? nxt.a : cA; const char* nB = has_next ? nxt.b : cB;
        for (int t = 0; t < nt; t += 2) {
            if constexpr (Epi::KWAIT) { if (t == nt - 6 && E.need_wait(cur)) E.do_wait(cur, wid); }
            const bool last = (t == nt - 2);
            const char* a1 = cA + (size_t)(t + 1) * kstep;
            const char* a2 = last ? nA : cA + (size_t)(t + 2) * kstep; const char* b2 = last ? nB : cB + (size_t)(t + 2) * kstep;
            const char* a3 = a2 + kstep; const char* b3 = b2 + kstep;
            PG8_LDB(B0, 0, 0); PG8_LDB(B1, 0, 1); PG8_SCHED; PG8_LDA(At, 0, 0); PG8_STAGE(PG8_SA(1, 1), a1 + hstep, voffA);
            PG8_WAIT_V(8); PG8_WAIT_L(0); PG8_BAR; PG8_MMA(0, 0, At, B0); PG8_MMA(0, 1, At, B1); PG8_BAR; PG8_SCHED;
            PG8_LDA(At, 0, 1); PG8_STAGE(PG8_SB(0, 0), b2, voffB); PG8_STAGE(PG8_SB(0, 1), b2 + hstep, voffB); PG8_STAGE(PG8_SA(0, 0), a2, voffA);
            PG8_WAIT_V(8); PG8_WAIT_L(0); PG8_BAR; PG8_MMA(1, 0, At, B0); PG8_MMA(1, 1, At, B1); PG8_BAR; PG8_SCHED;
            PG8_LDB(B0, 1, 0); PG8_LDB(B1, 1, 1); PG8_SCHED; PG8_LDA(At, 1, 0); PG8_STAGE(PG8_SA(0, 1), a2 + hstep, voffA);
            PG8_WAIT_V(8); PG8_WAIT_L(0); PG8_BAR; PG8_MMA(0, 0, At, B0); PG8_MMA(0, 1, At, B1); PG8_BAR; PG8_SCHED;
            PG8_LDA(At, 1, 1); PG8_STAGE(PG8_SB(1, 0), b3, voffB); PG8_STAGE(PG8_SB(1, 1), b3 + hstep, voffB); PG8_STAGE(PG8_SA(1, 0), a3, voffA);
            PG8_WAIT_V(8); PG8_WAIT_L(0); PG8_BAR; PG8_MMA(1, 0, At, B0); PG8_MMA(1, 1, At, B1); PG8_BAR; PG8_SCHED;
        }
        if (wr == 0) PG8_BAR;
        E(acc, cur, wr, wc, fr, fq);
        if (!has_next) break;
#pragma unroll
        for (int a = 0; a < 2; ++a)
#pragma unroll
            for (int b = 0; b < 2; ++b)
#pragma unroll
                for (int m = 0; m < 4; ++m)
#pragma unroll
                    for (int n = 0; n < 2; ++n) acc[a][b][m][n] = (f32x4){0.f, 0.f, 0.f, 0.f};
        cur = nxt; cA = nA; cB = nB; ++ui;
        if (wr == 1) PG8_BAR;
    }
    PG8_WAIT_V(0);
    PG8_BAR;
#undef PG8_SA
#undef PG8_SB
#undef PG8_STAGE
#undef PG8_LDA
#undef PG8_LDB
#undef PG8_MMA
#undef PG8_WAIT_V
#undef PG8_WAIT_L
#undef PG8_BAR
#undef PG8_SCHED
}
}

struct EpiGU {
    static constexpr bool PERM = true, KWAIT = false; bf16_t* H; const float* rss; const float* sw;
    DI void operator()(const f32x4 (&acc)[2][2][4][2], const pg8::Unit& u, int wr, int wc, int fr, int fq) const {
        asm volatile("" : "+v"(fr), "+v"(fq));
        const int row0 = u.pm * 256 + wr * 64 + fr, col0 = u.pn * 128 + wc * 32 + 8 * fq;
        const int cond = u.pm < 32 ? 0 : 1 + ((u.pm - 32) >> 3);
        const float* swp = sw + cond * 5632 + u.pn * 256 + wc * 32 + 8 * fq;
        const f32x4 sg0 = *(const f32x4*)(swp), sg1 = *(const f32x4*)(swp + 4), su0 = *(const f32x4*)(swp + 128), su1 = *(const f32x4*)(swp + 132);
        float rs8[8];
#pragma unroll
        for (int it = 0; it < 8; ++it) rs8[it] = rss[row0 + (it >> 2) * 128 + (it & 3) * 16];
#pragma unroll
        for (int ai = 0; ai < 2; ++ai)
#pragma unroll
            for (int m = 0; m < 4; ++m) {
                const int row = row0 + ai * 128 + m * 16;
                const float rstd = rsqrtf(rs8[ai * 4 + m] * (1.f / D) + EPS);
                bf16_t* rowp = H + (size_t)row * FH + col0;
                const f32x4 g0 = acc[ai][0][m][0] * rstd + sg0, g1 = acc[ai][0][m][1] * rstd + sg1, u0 = acc[ai][1][m][0] * rstd + su0, u1 = acc[ai][1][m][1] * rstd + su1;
                u32x4 w;
                w.x = pk2(silu_f(g0[0]) * u0[0], silu_f(g0[1]) * u0[1]); w.y = pk2(silu_f(g0[2]) * u0[2], silu_f(g0[3]) * u0[3]);
                w.z = pk2(silu_f(g1[0]) * u1[0], silu_f(g1[1]) * u1[1]); w.w = pk2(silu_f(g1[2]) * u1[2], silu_f(g1[3]) * u1[3]);
                *(u32x4*)rowp = w;
                __builtin_amdgcn_sched_barrier(0);
            }
    }
};
struct EpiRes {
    static constexpr bool PERM = false, KWAIT = true; float* out; const float* mod; const float* normg; unsigned char* ws; const float* xp; const float* xs; int l, gidx, ni; unsigned* tcnt;
    DI bool need_wait(const pg8::Unit& u) const { return tcnt != nullptr && u.pm >= 32; }
    DI void do_wait(const pg8::Unit& u, int wid) const {
        if (wid == 0) { unsigned sp = 0; while ((unsigned)__builtin_amdgcn_readfirstlane(__hip_atomic_load(tcnt + (u.pm - 32) * 16, __ATOMIC_RELAXED, __HIP_MEMORY_SCOPE_AGENT)) < 2u) { __builtin_amdgcn_s_sleep(2); if (++sp > (1u << 22)) break; }
            __builtin_amdgcn_fence(__ATOMIC_ACQUIRE, "agent"); asm volatile("s_waitcnt vmcnt(0)" ::: "memory"); }
        asm volatile("" ::: "memory"); __builtin_amdgcn_s_barrier(); asm volatile("" ::: "memory");
    }
    DI void operator()(const f32x4 (&acc)[2][2][4][2], const pg8::Unit& u, int wr, int wc, int fr, int fq) const {
        asm volatile("" : "+v"(fr), "+v"(fq));
        const int cond = u.pm < 32 ? 0 : 1 + ((u.pm - 32) >> 3);
        const float* gate = mod + (size_t)l * 3 * NMOD + (cond * 9 + gidx) * D;
        const float w = gidx == 5 ? 1.f : 0.5f;
        const bool nn = ni >= 0; const int nl = nn ? ni / 3 : 0, nj = nn ? ni - 3 * nl : 0;
        const float* ng = normg + (nn ? ni : 0) * D; const float* nscale = mod + (size_t)nl * 3 * NMOD + (cond * 9 + 3 * nj + 1) * D;
        float* rss = (float*)(ws + WS_CTL + WS_RSS) + (nn ? ni : 0) * MTOK; bf16_t* xn = (bf16_t*)(ws + WS_XN);
        const int col0 = u.pn * 256 + wc * 32 + 4 * fq;
        f32x4 gv[2][2], gs[2][2];
#pragma unroll
        for (int bj = 0; bj < 2; ++bj)
#pragma unroll
            for (int n = 0; n < 2; ++n) { const int c = col0 + bj * 128 + n * 16; gv[bj][n] = *(const f32x4*)(gate + c) * w;
                gs[bj][n] = *(const f32x4*)(ng + c) * (*(const f32x4*)(nscale + c) + 1.f); }
        const int rowb = u.pm * 256 + wr * 64 + fr;
        const float* rb = (l == 0 && gidx == 2) ? (u.pm < 32 ? xp : xs - (size_t)MP * D) : out;
        f32x4 bn[2][2];
#pragma unroll
        for (int bj = 0; bj < 2; ++bj)
#pragma unroll
            for (int n = 0; n < 2; ++n) bn[bj][n] = *(const f32x4*)(rb + (size_t)rowb * D + col0 + bj * 128 + n * 16);
#pragma unroll
        for (int it = 0; it < 8; ++it) {
            const int ai = it >> 2, m = it & 3;
            const int row = rowb + ai * 128 + m * 16;
            float* op = out + (size_t)row * D; float ss = 0.f;
            f32x4 bc[2][2];
#pragma unroll
            for (int bj = 0; bj < 2; ++bj)
#pragma unroll
                for (int n = 0; n < 2; ++n) bc[bj][n] = bn[bj][n];
            if (it < 7) { const int rown = rowb + ((it + 1) >> 2) * 128 + ((it + 1) & 3) * 16;
#pragma unroll
                for (int bj = 0; bj < 2; ++bj)
#pragma unroll
                    for (int n = 0; n < 2; ++n) bn[bj][n] = *(const f32x4*)(rb + (size_t)rown * D + col0 + bj * 128 + n * 16); }
#pragma unroll
            for (int bj = 0; bj < 2; ++bj)
#pragma unroll
                for (int n = 0; n < 2; ++n) { const int c = col0 + bj * 128 + n * 16; const f32x4 o = bc[bj][n] + gv[bj][n] * acc[ai][bj][m][n]; *(f32x4*)(op + c) = o;
                    if (nn) { ss += (o[0] * o[0] + o[1] * o[1]) + (o[2] * o[2] + o[3] * o[3]); const f32x4 y = o * gs[bj][n]; u32x2 pw; pw.x = pk2(y[0], y[1]); pw.y = pk2(y[2], y[3]); *(u32x2*)(xn + (size_t)row * D + c) = pw; } }
            if (nn) { ss = xor32_sum(xor16_sum(ss)); if (fq == 0) atomicAdd(rss + row, ss); }
            __builtin_amdgcn_sched_barrier(0);
        }
    }
};
struct EpiQKV {
    static constexpr bool PERM = false, KWAIT = false;
    bf16_t *qk, *vt; float* out; const float* gtab; const float* rss; const float* sw;
    DI void operator()(const f32x4 (&acc)[2][2][4][2], const pg8::Unit& u, int wr, int wc, int fr, int fq) const {
        asm volatile("" : "+v"(fr), "+v"(fq));
        if (u.kind == 0) {
            const int slot = u.pn * 4 + wc;
            if (slot >= 26) return;
            const int type = slot < 8 ? 0 : slot < 16 ? 1 : slot < 24 ? 2 : 3;
            const int h = slot - (type == 0 ? 0 : type == 1 ? 8 : type == 2 ? 16 : 24);
            const float* g = gtab + type * 64;
            bf16_t* dst = qk + (size_t)slot * MTOK * 64;
            const float qs = (type == 0 || type == 2) ? 0.125f * LOG2E : 1.f;
            const bool rope = (type >= 2) && (u.pm >= 32);
            f32x4 gv[2][2];
#pragma unroll
            for (int bj = 0; bj < 2; ++bj)
#pragma unroll
                for (int n = 0; n < 2; ++n) gv[bj][n] = *(const f32x4*)(g + 32 * bj + 16 * n + 4 * fq);
            const int cond = u.pm < 32 ? 0 : 1 + ((u.pm - 32) >> 3);
            f32x4 sv[2][2];
#pragma unroll
            for (int bj = 0; bj < 2; ++bj)
#pragma unroll
                for (int n = 0; n < 2; ++n) sv[bj][n] = *(const f32x4*)(sw + cond * 2560 + u.pn * 256 + bj * 128 + wc * 32 + 16 * n + 4 * fq);
            float rs8[8];
#pragma unroll
            for (int it = 0; it < 8; ++it) rs8[it] = rss[u.pm * 256 + (it >> 2) * 128 + wr * 64 + (it & 3) * 16 + fr];
            float freq[4];
#pragma unroll
            for (int i = 0; i < 4; ++i) freq[i] = __builtin_amdgcn_exp2f(-(float)(4 * fq + i) * (0.0625f * 13.287712379549449f));
#pragma unroll
            for (int ai = 0; ai < 2; ++ai)
#pragma unroll
                for (int m = 0; m < 4; ++m) {
                    const int row = u.pm * 256 + ai * 128 + wr * 64 + m * 16 + fr;
                    f32x4 y[2][2]; float ss = 0.f; const float rin = rsqrtf(rs8[ai * 4 + m] * (1.f / D) + EPS);
#pragma unroll
                    for (int bj = 0; bj < 2; ++bj)
#pragma unroll
                        for (int n = 0; n < 2; ++n) { y[bj][n] = acc[ai][bj][m][n] * rin + sv[bj][n]; const f32x4 x = y[bj][n]; ss += (x[0] * x[0] + x[1] * x[1]) + (x[2] * x[2] + x[3] * x[3]); }
                    ss = xor32_sum(xor16_sum(ss));
                    const float rstd = rsqrtf(ss * (1.f / 64.f) + EPS);
#pragma unroll
                    for (int bj = 0; bj < 2; ++bj)
#pragma unroll
                        for (int n = 0; n < 2; ++n) y[bj][n] = y[bj][n] * rstd * gv[bj][n];
                    if (rope) {
                        const int t = (row - MP) & 2047;
#pragma unroll
                        for (int bj = 0; bj < 2; ++bj) {
                            const float pos = (float)(bj == 0 ? (t >> 6) : (t & 63));
#pragma unroll
                            for (int i = 0; i < 4; ++i) {
                                const float ang = pos * freq[i]; const float sn = __sinf(ang), cs = __cosf(ang);
                                const float x1 = y[bj][0][i], x2 = y[bj][1][i];
                                y[bj][0][i] = x1 * cs - x2 * sn; y[bj][1][i] = x1 * sn + x2 * cs;
                            }
                        }
                    }
                    if (u.pm < 32 && (type == 1 || type == 3)) {
                        const size_t oo = (type == 1 ? O_NAK + (size_t)row * 512 : O_GK + (size_t)row * 128) + h * 64;
                        float* o = out + oo;
#pragma unroll
                        for (int bj = 0; bj < 2; ++bj)
#pragma unroll
                            for (int n = 0; n < 2; ++n) *(f32x4*)(o + 32 * bj + 16 * n + 4 * fq) = y[bj][n];
                    }
                    bf16_t* dp = dst + (size_t)row * 64 + 4 * fq;
#pragma unroll
                    for (int bj = 0; bj < 2; ++bj)
#pragma unroll
                        for (int n = 0; n < 2; ++n) { const f32x4 v = y[bj][n] * qs; u32x2 w; w.x = pk2(v[0], v[1]); w.y = pk2(v[2], v[3]); *(u32x2*)(dp + 32 * bj + 16 * n) = w; }
                    __builtin_amdgcn_sched_barrier(0);
                }
        } else {
            const int condt = u.pn < 32 ? 0 : 1 + ((u.pn - 32) >> 3);
            f32x4 rt[2][2]; float sw8[8];
#pragma unroll
            for (int bj = 0; bj < 2; ++bj)
#pragma unroll
                for (int n = 0; n < 2; ++n) { const f32x4 q4 = *(const f32x4*)(rss + u.pn * 256 + bj * 128 + wc * 32 + 16 * n + 4 * fq);
#pragma unroll
                    for (int i = 0; i < 4; ++i) rt[bj][n][i] = rsqrtf(q4[i] * (1.f / D) + EPS); }
#pragma unroll
            for (int it = 0; it < 8; ++it) { const int dv = u.pm * 256 + (it >> 2) * 128 + wr * 64 + (it & 3) * 16 + fr; sw8[it] = sw[condt * 2560 + 1792 + (dv < 768 ? dv : 0)]; }
#pragma unroll
            for (int ai = 0; ai < 2; ++ai)
#pragma unroll
                for (int m = 0; m < 4; ++m) {
                    const int dv = u.pm * 256 + ai * 128 + wr * 64 + m * 16 + fr;
                    if (dv < 640) {
                        const float swv = sw8[ai * 4 + m];
#pragma unroll
                        for (int bj = 0; bj < 2; ++bj)
#pragma unroll
                            for (int n = 0; n < 2; ++n) {
                                const int tok0 = u.pn * 256 + bj * 128 + wc * 32 + 16 * n + 4 * fq;
                                const f32x4 v = acc[ai][bj][m][n] * rt[bj][n] + swv;
                                u32x2 w; w.x = pk2(v[0], v[1]); w.y = pk2(v[2], v[3]);
                                *(u32x2*)(vt + (size_t)dv * MTOK + tok0) = w;
                                if (u.pn < 32) {
                                    if (dv < 512) { float* o = out + O_NAV + (size_t)tok0 * 512 + dv; o[0] = v[0]; o[512] = v[1]; o[1024] = v[2]; o[1536] = v[3]; }
                                    else { float* o = out + O_GV + (size_t)tok0 * 128 + (dv - 512); o[0] = v[0]; o[128] = v[1]; o[256] = v[2]; o[384] = v[3]; }
                                }
                            }
                    }
                    __builtin_amdgcn_sched_barrier(0);
                }
        }
    }
};
struct EpiSGU {
    static constexpr bool PERM = true, KWAIT = false; bf16_t* U; bf16_t* VTS; float* rowss; const float* rss; const float* sw;
    DI void operator()(const f32x4 (&acc)[2][2][4][2], const pg8::Unit& u, int wr, int wc, int fr, int fq) const {
        asm volatile("" : "+v"(fr), "+v"(fq));
        const int r0 = u.pm * 256 + wr * 64 + fr, c0 = u.pn * 256 + wc * 32 + 8 * fq;
        bf16_t* base = u.kind ? VTS : U; const size_t ld = u.kind ? (size_t)MTOK : (size_t)2048;
        const int condc = u.kind ? (u.pn < 32 ? 0 : 1 + ((u.pn - 32) >> 3)) : (u.pm < 32 ? 0 : 1 + ((u.pm - 32) >> 3));
        f32x4 cs[2][2];
#pragma unroll
        for (int bj = 0; bj < 2; ++bj)
#pragma unroll
            for (int n = 0; n < 2; ++n) {
                if (u.kind == 0) cs[bj][n] = *(const f32x4*)(sw + condc * 4096 + c0 + bj * 128 + 4 * n);
                else { const f32x4 q4 = *(const f32x4*)(rss + c0 + bj * 128 + 4 * n);
#pragma unroll
                    for (int i = 0; i < 4; ++i) cs[bj][n][i] = rsqrtf(q4[i] * (1.f / D) + EPS); }
            }
        f32x4 sq[2][2];
#pragma unroll
        for (int bj = 0; bj < 2; ++bj)
#pragma unroll
            for (int n = 0; n < 2; ++n) sq[bj][n] = (f32x4){0.f, 0.f, 0.f, 0.f};
        float rs8[8];
#pragma unroll
        for (int it = 0; it < 8; ++it) { const int row = r0 + (it >> 2) * 128 + (it & 3) * 16; rs8[it] = u.kind ? sw[condc * 4096 + 2048 + row] : rss[row]; }
#pragma unroll
        for (int ai = 0; ai < 2; ++ai)
#pragma unroll
            for (int m = 0; m < 4; ++m) {
                const int row = r0 + ai * 128 + m * 16;
                const float rsc = u.kind ? rs8[ai * 4 + m] : rsqrtf(rs8[ai * 4 + m] * (1.f / D) + EPS);
                bf16_t* rowp = base + (size_t)row * ld + c0;
#pragma unroll
                for (int bj = 0; bj < 2; ++bj) {
                    const f32x4 x0 = u.kind ? acc[ai][bj][m][0] * cs[bj][0] + rsc : acc[ai][bj][m][0] * rsc + cs[bj][0];
                    const f32x4 x1 = u.kind ? acc[ai][bj][m][1] * cs[bj][1] + rsc : acc[ai][bj][m][1] * rsc + cs[bj][1];
                    const f32x4 a = gelu4(x0), b = gelu4(x1);
                    sq[bj][0] += a * a; sq[bj][1] += b * b;
                    u32x4 w; w.x = pk2(a[0], a[1]); w.y = pk2(a[2], a[3]); w.z = pk2(b[0], b[1]); w.w = pk2(b[2], b[3]); *(u32x4*)(rowp + bj * 128) = w; }
                __builtin_amdgcn_sched_barrier(0);
            }
        if (u.kind) {
#pragma unroll
            for (int bj = 0; bj < 2; ++bj)
#pragma unroll
                for (int n = 0; n < 2; ++n)
#pragma unroll
                    for (int i = 0; i < 4; ++i) {
                        float s = sq[bj][n][i];
                        s = row16_sum(s);
                        if (fr == 0) atomicAdd(rowss + c0 + bj * 128 + 4 * n + i, s);
                    }
        }
    }
};

struct TItem { const float* src; bf16_t* dst0; bf16_t* dst1; int ldw, Kd; };
DI void titem_load(const TItem& t, int lane, float (&v)[64]) {
#pragma unroll
    for (int i = 0; i < 64; ++i) v[i] = t.src[(size_t)i * t.ldw + lane];
}
DI void titem_finish(const TItem& t, LAS float* scr, int lane, const float (&v)[64]) {
#pragma unroll
    for (int i = 0; i < 64; ++i) scr[i * 65 + lane] = v[i];
    asm volatile("s_waitcnt lgkmcnt(0)" ::: "memory");
    const int c = lane & 7;
#pragma unroll
    for (int j = 0; j < 8; ++j) { const int n = (lane >> 3) + 8 * j; const LAS float* s = scr + (8 * c) * 65 + n;
        u32x4 o; o.x = pk2(s[0 * 65], s[1 * 65]); o.y = pk2(s[2 * 65], s[3 * 65]); o.z = pk2(s[4 * 65], s[5 * 65]); o.w = pk2(s[6 * 65], s[7 * 65]);
        bf16_t* d = (j < 4 ? t.dst0 + (size_t)n * t.Kd : t.dst1 + (size_t)(n - 32) * t.Kd) + 8 * c;
        *(u32x4*)d = o; }
    asm volatile("s_waitcnt lgkmcnt(0)" ::: "memory");
}
DI void convert_list(const Params& p, unsigned char* ws, LAS unsigned char* lds, int mask, int gw, int ngw, int wid, int lane) {
    LAS float* scr = (LAS float*)(lds + wid * 16640);
    int NIT = 0;
#pragma unroll
    for (int m = 0; m < 12; ++m) { const int cnt = m < 4 ? 1408 : m < 8 ? 704 : m == 8 ? 576 : m == 9 ? 256 : m == 10 ? 1024 : 512; if ((mask >> m) & 1) NIT += cnt; }
    auto decode = [&](int a, TItem& t) {
        int mm = 0, r = a; bool found = false;
#pragma unroll
        for (int m = 0; m < 12; ++m) { const int cnt = m < 4 ? 1408 : m < 8 ? 704 : m == 8 ? 576 : m == 9 ? 256 : m == 10 ? 1024 : 512;
            if (!found && ((mask >> m) & 1)) { if (r < cnt) { mm = m; found = true; } else r -= cnt; } }
        const float* W; bf16_t* WT; int ldw, Kd, k0, n0, drow0, drow1;
        if (mm < 4) { const int mi = mm, l = mi >> 1, f = mi & 1;
            W = (f ? p.in[13] : p.in[11]) + (size_t)l * D * 5632; const int kb = r / 88, nb = r % 88; n0 = nb * 64; k0 = kb * 64; ldw = 5632; Kd = D;
            drow0 = n0 < FH ? (n0 >> 7) * 256 + (n0 & 127) : ((n0 - FH) >> 7) * 256 + 128 + ((n0 - FH) & 127); drow1 = drow0 + 32;
            WT = (bf16_t*)(ws + WS_W + (size_t)mi * FFN_STRIDE); }
        else if (mm < 8) { const int mi = mm - 4, l = mi >> 1, f = mi & 1;
            W = (f ? p.in[14] : p.in[12]) + (size_t)l * FH * D; const int kb = r / 16, nb = r % 16; n0 = nb * 64; k0 = kb * 64; ldw = D; Kd = FH; drow0 = n0; drow1 = n0 + 32;
            WT = (bf16_t*)(ws + WS_W + (size_t)mi * FFN_STRIDE + FFN_DOWN); }
        else if (mm == 8) { const int kb = r / 36, slot = r % 36; n0 = slot * 64; k0 = kb * 64; ldw = 2304; Kd = D; W = p.in[15];
            if (slot >= 16 && slot < 24) { WT = (bf16_t*)(ws + WS_WV); drow0 = (slot - 16) * 64; drow1 = drow0 + 32; }
            else if (slot >= 34) { WT = (bf16_t*)(ws + WS_WV); drow0 = 512 + (slot - 34) * 64; drow1 = drow0 + 32; }
            else { const int q = slot < 16 ? slot : slot - 8; WT = (bf16_t*)(ws + WS_WQK); drow0 = (q >> 2) * 256 + 32 * (q & 3); drow1 = drow0 + 128; } }
        else if (mm == 9) { const int kb = r / 16, nb = r % 16; n0 = nb * 64; k0 = kb * 64; ldw = D; Kd = D; W = p.in[16]; WT = (bf16_t*)(ws + WS_WO); drow0 = n0; drow1 = n0 + 32; }
        else if (mm == 10) { const int kb = r / 64, nb = r % 64; n0 = nb * 64; k0 = kb * 64; ldw = 4096; Kd = D; W = p.in[22]; WT = (bf16_t*)(ws + WS_WSI); drow0 = n0; drow1 = n0 + 32; }
        else { const int kb = r / 16, nb = r % 16; n0 = nb * 64; k0 = kb * 64; ldw = D; Kd = 2048; W = p.in[26]; WT = (bf16_t*)(ws + WS_WSO); drow0 = n0; drow1 = n0 + 32; }
        t.src = W + (size_t)k0 * ldw + n0; t.dst0 = WT + (size_t)drow0 * Kd + k0; t.dst1 = WT + (size_t)drow1 * Kd + k0; t.ldw = ldw; t.Kd = Kd;
    };
    for (int it = gw; it < NIT; it += ngw) { TItem cur; float vc[64]; decode(it, cur); titem_load(cur, lane, vc); titem_finish(cur, scr, lane, vc); }
}
DI void mod_gemv(const Params& p, unsigned char* ws, LAS unsigned char* lds, int l_lo, int l_hi, int gw, int ngw, int tid, int lane) {
    LAS float* silu = (LAS float*)lds;
    for (int i = tid; i < 3072; i += 512) { const int ci = i >> 10, k = i & 1023; const float x = ci == 0 ? p.in[7][k] : p.in[6][(ci - 1) * D + k]; silu[i] = x / (1.f + __expf(-x)); }
    __syncthreads();
    float* mod = (float*)(ws + WS_MOD);
    const int ntask = (l_hi - l_lo) * 4608;
    for (int id = gw; id < ntask; id += ngw) {
        const int l = l_lo + id / 4608, r = id % 4608, kc = r / 144, st = r - kc * 144, n0 = st * 64, k0 = kc * 32;
        const float* w = p.in[9] + (size_t)l * D * NMOD + (size_t)k0 * NMOD + n0 + lane;
        float wv[32];
#pragma unroll
        for (int kk = 0; kk < 32; ++kk) wv[kk] = w[(size_t)kk * NMOD];
        float a0 = 0.f, a1 = 0.f, a2 = 0.f;
#pragma unroll
        for (int kk = 0; kk < 32; ++kk) { a0 += silu[k0 + kk] * wv[kk]; a1 += silu[1024 + k0 + kk] * wv[kk]; a2 += silu[2048 + k0 + kk] * wv[kk]; }
        if (kc == 0) { const float bb = p.in[10][l * NMOD + n0 + lane]; a0 += bb; a1 += bb; a2 += bb; }
        atomicAdd(mod + (size_t)(l * 3 + 0) * NMOD + n0 + lane, a0); atomicAdd(mod + (size_t)(l * 3 + 1) * NMOD + n0 + lane, a1); atomicAdd(mod + (size_t)(l * 3 + 2) * NMOD + n0 + lane, a2);
    }
    __syncthreads();
}
DI void conv_caches(const Params& p, unsigned char* ws, int gt, int nth) {
    bf16_t* kcna = (bf16_t*)(ws + WS_KCNA); bf16_t* vcnat = (bf16_t*)(ws + WS_VCNAT); bf16_t* kcg = (bf16_t*)(ws + WS_KCG); bf16_t* vcgt = (bf16_t*)(ws + WS_VCGT);
    for (int i = gt; i < 524288; i += nth) {
        { const int d = i & 63, l = (i >> 6) & 511, h = (i >> 15) & 7, b = i >> 18; kcna[i] = (bf16_t)pk2(p.in[2][((size_t)(b * 512 + l) * 8 + h) * 64 + d], 0.f); }
        { const int l = i & 511, d = (i >> 9) & 63, h = (i >> 15) & 7, b = i >> 18; vcnat[i] = (bf16_t)pk2(p.in[3][((size_t)(b * 512 + l) * 8 + h) * 64 + d], 0.f); }
    }
    for (int i = gt; i < 131072; i += nth) {
        { const int d = i & 63, l = (i >> 6) & 511, kv = (i >> 15) & 1, b = i >> 16; kcg[i] = (bf16_t)pk2(p.in[4][((size_t)(b * 512 + l) * 2 + kv) * 64 + d], 0.f); }
        { const int l = i & 511, d = (i >> 9) & 63, kv = (i >> 15) & 1, b = i >> 16; vcgt[i] = (bf16_t)pk2(p.in[5][((size_t)(b * 512 + l) * 2 + kv) * 64 + d], 0.f); }
    }
}
DI void prep_phase(const Params& p, unsigned char* ws, LAS unsigned char* lds, int tid, int wid, int lane, int cb, int G) {
    mod_gemv(p, ws, lds, 0, G > 192 ? 1 : 2, cb * 8 + wid, G * 8, tid, lane);
    {
        const int gt = cb * 512 + tid, nth = G * 512;
        if (G <= 192) conv_caches(p, ws, gt, nth);
        unsigned* z0a = (unsigned*)(ws + WS_WQK + (size_t)1600 * D * 2); unsigned* z0b = (unsigned*)(ws + WS_WQK + (size_t)1728 * D * 2); unsigned* z1 = (unsigned*)(ws + WS_WV + (size_t)640 * D * 2);
        for (int i = gt; i < 65536; i += nth) { if (i < 32768) z0a[i] = 0u; else z0b[i - 32768] = 0u; z1[i] = 0u; }
        if (gt < 256) { const int ty = gt >> 6, d = gt & 63; ((float*)(ws + WS_GTAB))[gt] = ty == 0 ? p.in[17][d] : ty == 1 ? p.in[18][d] : ty == 2 ? p.in[20][d] : p.in[21][d]; }
    }
    convert_list(p, ws, lds, G > 192 ? 0x111 : 0xfff, cb * 8 + wid, G * 8, wid, lane);
}

DI void sw_rows(const Params& p, unsigned char* ws, int sel, int gw, int ngw, int lane) {
    float* swb = (float*)(ws + WS_SW); const float* mod = (const float*)(ws + WS_MOD);
#pragma unroll 1
    for (int ci = 0; ci < 7; ++ci) {
        if (!((sel >> ci) & 1)) continue;
        const bf16_t* W; int l, j, nrows, cstride; float* o;
        if (ci < 4) { W = (const bf16_t*)(ws + WS_W + (size_t)ci * FFN_STRIDE); l = ci >> 1; j = (ci & 1) ? 2 : 0; o = swb + ci * 3 * 5632; cstride = 5632; nrows = 5632; }
        else if (ci == 4) { W = (const bf16_t*)(ws + WS_WQK); l = 0; j = 1; o = swb + SW_QKV; cstride = 2560; nrows = 1792; }
        else if (ci == 5) { W = (const bf16_t*)(ws + WS_WV); l = 0; j = 1; o = swb + SW_QKV + 1792; cstride = 2560; nrows = 768; }
        else { W = (const bf16_t*)(ws + WS_WSI); l = 1; j = 1; o = swb + SW_SGU; cstride = 4096; nrows = 4096; }
        f32x4 sh[3][4];
#pragma unroll
        for (int c = 0; c < 3; ++c)
#pragma unroll
            for (int q = 0; q < 4; ++q) sh[c][q] = *(const f32x4*)(mod + (size_t)(l * 3 + c) * NMOD + 3 * j * D + lane * 16 + 4 * q);
        for (int row = gw; row < nrows; row += ngw) {
            const u32x4 w0 = *(const u32x4*)(W + (size_t)row * D + lane * 16), w1 = *(const u32x4*)(W + (size_t)row * D + lane * 16 + 8);
            float wf[16];
#pragma unroll
            for (int i = 0; i < 4; ++i) { wf[2 * i] = __builtin_bit_cast(float, w0[i] << 16); wf[2 * i + 1] = __builtin_bit_cast(float, w0[i] & 0xffff0000u);
                                          wf[8 + 2 * i] = __builtin_bit_cast(float, w1[i] << 16); wf[8 + 2 * i + 1] = __builtin_bit_cast(float, w1[i] & 0xffff0000u); }
            float a3[3];
#pragma unroll
            for (int c = 0; c < 3; ++c) { float a = 0.f;
#pragma unroll
                for (int q = 0; q < 4; ++q) a += (wf[4 * q] * sh[c][q][0] + wf[4 * q + 1] * sh[c][q][1]) + (wf[4 * q + 2] * sh[c][q][2] + wf[4 * q + 3] * sh[c][q][3]);
                a3[c] = wave_sum(a); }
            if (lane < 3) o[lane * cstride + row] = lane == 0 ? a3[0] : lane == 1 ? a3[1] : a3[2];
        }
    }
}

DI void phase1(const Params& p, unsigned char* ws, int gw, int ngw, int lane) {
    const float* mod = (const float*)(ws + WS_MOD);
    {
        const float* g = p.in[8];
        bf16_t* xn = (bf16_t*)(ws + WS_XN); float* rss0 = (float*)(ws + WS_CTL + WS_RSS);
        for (int m = gw; m < MTOK; m += ngw) {
            const int cond = m < MP ? 0 : 1 + ((m - MP) >> 11);
            const float* row = m < MP ? p.in[0] + (size_t)m * D : p.in[1] + (size_t)(m - MP) * D;
            const float* sc = mod + (cond * 9 + 1) * D;
            f32x4 v[4]; float ss = 0.f;
#pragma unroll
            for (int jj = 0; jj < 4; ++jj) { v[jj] = *(const f32x4*)(row + 4 * lane + 256 * jj); ss += (v[jj][0] * v[jj][0] + v[jj][1] * v[jj][1]) + (v[jj][2] * v[jj][2] + v[jj][3] * v[jj][3]); }
            ss = wave_sum(ss);
            if (lane == 0) rss0[m] = ss;
#pragma unroll
            for (int jj = 0; jj < 4; ++jj) { const int col = 4 * lane + 256 * jj;
                const f32x4 gg = *(const f32x4*)(g + col), s1 = *(const f32x4*)(sc + col);
                const f32x4 y = v[jj] * gg * (s1 + 1.f);
                u32x2 w; w.x = pk2(y[0], y[1]); w.y = pk2(y[2], y[3]); *(u32x2*)(xn + (size_t)m * D + col) = w; }
        }
    }
    sw_rows(p, ws, ngw > 1536 ? 0x31 : 0x7f, gw, ngw, lane);
}

#define MFMA32(a, b, c) __builtin_amdgcn_mfma_f32_32x32x16_bf16((a), (b), (c), 0, 0, 0)
constexpr int AT_ROW = 144;
constexpr int AT_KBUF = 0, AT_VBUF = 2 * 64 * AT_ROW, AT_RPB = 4 * 64 * AT_ROW, AT_TASK = AT_RPB + 2048;
struct ATask { const bf16_t* k0; const bf16_t* vt0; const bf16_t* kc; const bf16_t* vtc; int type, nsteps, urow0; };
DI void at_src(const ATask& T, int u, const bf16_t*& k, const bf16_t*& vt, int& vld) {
    if (T.type == 0) { k = T.k0 + (size_t)u * 4096; vt = T.vt0 + u * 64; vld = MTOK; }
    else if (T.type == 1) { if (u < 32) { k = T.k0 + (size_t)u * 4096; vt = T.vt0 + u * 64; vld = MTOK; } else { k = T.kc + (size_t)(u - 32) * 4096; vt = T.vtc + (u - 32) * 64; vld = 512; } }
    else { if (u < 8) { k = T.kc + (size_t)u * 4096; vt = T.vtc + u * 64; vld = 512; } else { const int tok = (T.urow0 + (u - 8)) * 64; k = T.k0 + (size_t)tok * 64; vt = T.vt0 + tok; vld = MTOK; } }
}
DI void at_gload(const ATask& T, int u, int tid, u32x4& a, u32x4& b) {
    const bf16_t* k; const bf16_t* vt; int vld; at_src(T, u, k, vt, vld);
    if (tid < 256) { const bf16_t* p = k + (tid >> 3) * 64 + (tid & 7) * 8; a = *(const u32x4*)p; b = *(const u32x4*)(p + 32 * 64); }
    else { const int j = tid - 256; const bf16_t* p = vt + (size_t)(j >> 2) * vld + (j & 3) * 8; a = *(const u32x4*)p; b = *(const u32x4*)(p + 32); }
}
DI void at_lstore(LAS unsigned char* lds, int buf, int tid, u32x4 a, u32x4 b) {
    if (tid < 256) { LAS unsigned char* p = lds + AT_KBUF + buf * 64 * AT_ROW + (tid >> 3) * AT_ROW + (tid & 7) * 16; *(LAS u32x4*)p = a; *(LAS u32x4*)(p + 32 * AT_ROW) = b; }
    else { const int j = tid - 256, c = j & 3, s = c >> 1, sec = c & 1; LAS unsigned char* row = lds + AT_VBUF + buf * 64 * AT_ROW + (j >> 2) * AT_ROW;
        const int o0 = ((s * 2 + 0) * 2 + sec) * 8, o1 = ((s * 2 + 1) * 2 + sec) * 8;
        *(LAS u32x2*)(row + o0) = (u32x2){a.x, a.y}; *(LAS u32x2*)(row + o1) = (u32x2){a.z, a.w};
        *(LAS u32x2*)(row + 64 + o0) = (u32x2){b.x, b.y}; *(LAS u32x2*)(row + 64 + o1) = (u32x2){b.z, b.w}; }
}
DI void attn_phase(const Params& p, unsigned char* ws, LAS unsigned char* lds, int tid, int wid, int lane, int rep) {
    unsigned char* R = ws + WS_R;
    const bf16_t* QNA = (const bf16_t*)(R + R_QNA); const bf16_t* KNA = (const bf16_t*)(R + R_KNA); const bf16_t* QG = (const bf16_t*)(R + R_QG); const bf16_t* KG = (const bf16_t*)(R + R_KG);
    const bf16_t* VT = (const bf16_t*)(R + R_VT); bf16_t* AO = (bf16_t*)(R + R_AO);
    const bf16_t* KCNA = (const bf16_t*)(ws + WS_KCNA); const bf16_t* VCNAT = (const bf16_t*)(ws + WS_VCNAT); const bf16_t* KCG = (const bf16_t*)(ws + WS_KCG); const bf16_t* VCGT = (const bf16_t*)(ws + WS_VCGT);
    unsigned* counter = (unsigned*)(ws + WS_CTL) + 64 * rep;
    LAS float* rpb_l = (LAS float*)(lds + AT_RPB); volatile LAS int* taskw = (volatile LAS int*)(lds + AT_TASK);
    const int r32 = lane & 31, hi = lane >> 5;
    for (;;) {
        if (tid == 0) taskw[0] = (int)atomicAdd(counter, 1u);
        __syncthreads();
        const int t = __builtin_amdgcn_readfirstlane(taskw[0]);
        if (t >= 768) break;
        ATask T; T.kc = nullptr; T.vtc = nullptr; T.urow0 = 0;
        const bf16_t* q; bf16_t* o; int r = 0, cblk = 0, row0 = 0;
        if (t < 128) {
            const int b = t >> 6, kv = (t >> 5) & 1, grp = t & 31, qh = kv * 4 + (grp >> 3), qb = (grp & 7) * 8 + wid, tok0 = MP + b * 2048;
            q = QG + ((size_t)qh * MTOK + tok0 + qb * 32) * 64; T.k0 = KG + ((size_t)kv * MTOK + tok0) * 64; T.vt0 = VT + (size_t)(512 + kv * 64) * MTOK + tok0;
            T.kc = KCG + (size_t)((b * 2 + kv) * 512) * 64; T.vtc = VCGT + (size_t)((b * 2 + kv) * 64) * 512; o = AO + (size_t)(tok0 + qb * 32) * D + 512 + qh * 64; T.type = 1; T.nsteps = 40;
        } else if (t < 256) {
            const int i = t - 128, b = i >> 6, h = (i >> 3) & 7, rg = i & 7, tok0 = MP + b * 2048;
            r = 4 * rg + (wid >> 1); cblk = wid & 1; row0 = min(max(r - 4, 0), 24);
            T.urow0 = min(max(4 * rg - 4, 0), 24); const int urow1 = min(max(4 * rg - 1, 0), 24) + 7;
            const int qb = r * 2 + cblk;
            q = QNA + ((size_t)h * MTOK + tok0 + qb * 32) * 64; T.k0 = KNA + ((size_t)h * MTOK + tok0) * 64; T.vt0 = VT + (size_t)(h * 64) * MTOK + tok0;
            T.kc = KCNA + (size_t)((b * 8 + h) * 512) * 64; T.vtc = VCNAT + (size_t)((b * 8 + h) * 64) * 512; o = AO + (size_t)(tok0 + qb * 32) * D + h * 64; T.type = 2; T.nsteps = 8 + (urow1 - T.urow0 + 1);
            if (tid < 465) rpb_l[tid] = p.in[19][h * 465 + tid] * LOG2E;
        } else {
            const int i = t - 256, isB = i >> 8, j = i & 255, b = j >> 3, h = j & 7, tok0 = b * 256, qb = wid;
            if (!isB) { q = QNA + ((size_t)h * MTOK + tok0 + qb * 32) * 64; T.k0 = KNA + ((size_t)h * MTOK + tok0) * 64; T.vt0 = VT + (size_t)(h * 64) * MTOK + tok0; o = AO + (size_t)(tok0 + qb * 32) * D + h * 64; }
            else { const int kv = h >> 2; q = QG + ((size_t)h * MTOK + tok0 + qb * 32) * 64; T.k0 = KG + ((size_t)kv * MTOK + tok0) * 64; T.vt0 = VT + (size_t)(512 + kv * 64) * MTOK + tok0; o = AO + (size_t)(tok0 + qb * 32) * D + 512 + h * 64; }
            T.type = 0; T.nsteps = 4;
        }
        const int ns = T.nsteps;
        u32x4 pa, pb, pc, pd; at_gload(T, 0, tid, pc, pd); at_gload(T, 1, tid, pa, pb);
        bf16x8 qf[4];
#pragma unroll
        for (int ks = 0; ks < 4; ++ks) qf[ks] = *(const bf16x8*)(q + r32 * 64 + ks * 16 + hi * 8);
        at_lstore(lds, 0, tid, pc, pd);
        float mrun = -1e30f, lrun = 0.f; f32x16 o0, o1;
#pragma unroll
        for (int i = 0; i < 16; ++i) { o0[i] = 0.f; o1[i] = 0.f; }
        __syncthreads();
        for (int u = 0; u < ns; ++u) {
            if (u + 1 < ns) at_lstore(lds, (u + 1) & 1, tid, pa, pb);
            if (u + 2 < ns) at_gload(T, u + 2, tid, pa, pb);
            bool active = true; const bool local = (T.type == 2 && u >= 8); int kr = 0;
            if (local) { kr = T.urow0 + (u - 8); active = (kr >= row0) && (kr < row0 + 8); }
            if (active) {
                const LAS unsigned char* kb = lds + AT_KBUF + (u & 1) * 64 * AT_ROW + r32 * AT_ROW + hi * 16;
                const LAS unsigned char* vb = lds + AT_VBUF + (u & 1) * 64 * AT_ROW + r32 * AT_ROW + hi * 16;
                f32x16 st[2];
#pragma unroll
                for (int h2 = 0; h2 < 2; ++h2) {
                    bf16x8 kf[4];
#pragma unroll
                    for (int ks = 0; ks < 4; ++ks) kf[ks] = *(const LAS bf16x8*)(kb + h2 * 32 * AT_ROW + ks * 32);
#pragma unroll
                    for (int i = 0; i < 16; ++i) st[h2][i] = 0.f;
#pragma unroll
                    for (int ks = 0; ks < 4; ++ks) st[h2] = MFMA32(kf[ks], qf[ks], st[h2]);
                }
                if (local) {
                    const int dr = kr - r + 7; const int qc = 32 * cblk + r32; const int wsq = min(max(qc - 8, 0), 48);
#pragma unroll
                    for (int h2 = 0; h2 < 2; ++h2) {
                        const int base = dr * 31 + 15 - qc + 32 * h2 + 4 * hi;
#pragma unroll
                        for (int i = 0; i < 16; ++i) { const int ko = (i & 3) + 8 * (i >> 2); const int kc = 32 * h2 + 4 * hi + ko; const bool ok = (kc >= wsq) && (kc < wsq + 16);
                            const float bias = rpb_l[ok ? base + ko : 0]; st[h2][i] = ok ? st[h2][i] + bias : -1e30f; }
                    }
                }
                float mx = fmaxf(fmaxf(st[0][0], st[0][1]), fmaxf(st[1][0], st[1][1]));
#pragma unroll
                for (int i = 2; i < 16; i += 2) mx = fmaxf(mx, fmaxf(fmaxf(st[0][i], st[0][i + 1]), fmaxf(st[1][i], st[1][i + 1])));
                mx = xor32_max(mx);
                if (__any(mx > mrun)) {
                    const float mnew = fmaxf(mrun, mx), alpha = __builtin_amdgcn_exp2f(mrun - mnew); mrun = mnew;
                    lrun *= alpha;
#pragma unroll
                    for (int i = 0; i < 16; ++i) { o0[i] *= alpha; o1[i] *= alpha; }
                }
                float ps0 = 0.f, ps1 = 0.f;
#pragma unroll
                for (int i = 0; i < 16; ++i) { st[0][i] = __builtin_amdgcn_exp2f(st[0][i] - mrun); ps0 += st[0][i]; st[1][i] = __builtin_amdgcn_exp2f(st[1][i] - mrun); ps1 += st[1][i]; }
                lrun += ps0 + ps1;
#pragma unroll
                for (int h2 = 0; h2 < 2; ++h2) {
                    u32x4 p0, p1;
                    p0.x = pk2(st[h2][0], st[h2][1]); p0.y = pk2(st[h2][2], st[h2][3]); p0.z = pk2(st[h2][4], st[h2][5]); p0.w = pk2(st[h2][6], st[h2][7]);
                    p1.x = pk2(st[h2][8], st[h2][9]); p1.y = pk2(st[h2][10], st[h2][11]); p1.z = pk2(st[h2][12], st[h2][13]); p1.w = pk2(st[h2][14], st[h2][15]);
                    const bf16x8 pf0 = __builtin_bit_cast(bf16x8, p0), pf1 = __builtin_bit_cast(bf16x8, p1);
                    bf16x8 vf[4];
#pragma unroll
                    for (int db = 0; db < 2; ++db)
#pragma unroll
                        for (int s = 0; s < 2; ++s) vf[db * 2 + s] = *(const LAS bf16x8*)(vb + db * 32 * AT_ROW + h2 * 64 + s * 32);
                    o0 = MFMA32(vf[0], pf0, o0); o0 = MFMA32(vf[1], pf1, o0);
                    o1 = MFMA32(vf[2], pf0, o1); o1 = MFMA32(vf[3], pf1, o1);
                }
            }
            __syncthreads();
        }
        lrun = xor32_sum(lrun);
        const float inv = 1.f / lrun;
        bf16_t* op = o + (size_t)r32 * D + 4 * hi;
#pragma unroll
        for (int gq = 0; gq < 4; ++gq) {
            u32x2 w0, w1;
            w0.x = pk2(o0[4 * gq] * inv, o0[4 * gq + 1] * inv); w0.y = pk2(o0[4 * gq + 2] * inv, o0[4 * gq + 3] * inv);
            w1.x = pk2(o1[4 * gq] * inv, o1[4 * gq + 1] * inv); w1.y = pk2(o1[4 * gq + 2] * inv, o1[4 * gq + 3] * inv);
            *(u32x2*)(op + 8 * gq) = w0; *(u32x2*)(op + 32 + 8 * gq) = w1;
        }
    }
}

DI void spatial_phase(const Params& p, unsigned char* ws, LAS unsigned char* lds, int tid, int wid, int lane, int cb, int G) {
    unsigned char* R = ws + WS_R;
    bf16_t* U = (bf16_t*)(R + R_U); const bf16_t* VTS = (const bf16_t*)(R + R_VTS);
    const float* rowss = (const float*)(ws + WS_CTL + 4096);
    const float* Ws = p.in[24]; const float* bs = p.in[25]; const float* vg = p.in[23];
    const int r32 = lane & 31, hi = lane >> 5, tb = wid & 3, dh = wid >> 2;
    for (int unit = cb; unit < 768; unit += G) {
        const int c = unit >> 3, g = unit & 7;
        const int t = 128 * c + 32 * tb + r32;
        u32x4 stg[8];
#pragma unroll
        for (int j = 0; j < 8; ++j) stg[j] = *(const u32x4*)(VTS + (size_t)(256 * g + (tid >> 4) + 32 * j) * MTOK + 128 * c + (tid & 15) * 8);
        f32x4 wst[8];
#pragma unroll
        for (int j = 0; j < 8; ++j) wst[j] = *(const f32x4*)(Ws + ((size_t)g * 128 + (tid >> 5) + 16 * j) * 128 + (tid & 31) * 4);
        const f32x4 rq = *(const f32x4*)(rowss + 128 * c + (tid & 31) * 4);
        u32x2 uu[4][4];
#pragma unroll
        for (int db = 0; db < 4; ++db)
#pragma unroll
            for (int gq = 0; gq < 4; ++gq) uu[db][gq] = *(const u32x2*)(U + (size_t)t * 2048 + 256 * g + 128 * dh + 32 * db + 8 * gq + 4 * hi);
        __syncthreads();
#pragma unroll
        for (int j = 0; j < 8; ++j) *(LAS u32x4*)(lds + ((tid >> 4) + 32 * j) * 272 + (tid & 15) * 16) = stg[j];
        { f32x4 r4;
#pragma unroll
          for (int i = 0; i < 4; ++i) r4[i] = rsqrtf(rq[i] * (1.f / 2048.f) + EPS);
#pragma unroll
          for (int j = 0; j < 8; ++j) { const f32x4 w = wst[j] * r4; u32x2 pw; pw.x = pk2(w[0], w[1]); pw.y = pk2(w[2], w[3]); *(LAS u32x2*)(lds + 69632 + ((tid >> 5) + 16 * j) * 272 + (tid & 31) * 8) = pw; } }
        __syncthreads();
        bf16x8 bfr[8];
#pragma unroll
        for (int ks = 0; ks < 8; ++ks) bfr[ks] = *(const LAS bf16x8*)(lds + 69632 + (32 * tb + r32) * 272 + (16 * ks + 8 * hi) * 2);
        const float bias = bs[g * 128 + 32 * tb + r32];
#pragma unroll
        for (int db = 0; db < 4; ++db) {
            f32x4 vg4[4];
#pragma unroll
            for (int gq = 0; gq < 4; ++gq) vg4[gq] = *(const f32x4*)(vg + 256 * g + 128 * dh + 32 * db + 8 * gq + 4 * hi);
            f32x16 acc;
#pragma unroll
            for (int i = 0; i < 16; ++i) acc[i] = 0.f;
#pragma unroll
            for (int ks = 0; ks < 8; ++ks) { const bf16x8 a = *(const LAS bf16x8*)(lds + (128 * dh + 32 * db + r32) * 272 + (16 * ks + 8 * hi) * 2); acc = MFMA32(a, bfr[ks], acc); }
#pragma unroll
            for (int gq = 0; gq < 4; ++gq) { const int d = 256 * g + 128 * dh + 32 * db + 8 * gq + 4 * hi;
                bf16_t* up = U + (size_t)t * 2048 + d; const u32x2 u2 = uu[db][gq];
                const float u0 = bf2f((unsigned short)(u2.x & 0xffffu)), u1 = bf2f((unsigned short)(u2.x >> 16)), u2f = bf2f((unsigned short)(u2.y & 0xffffu)), u3 = bf2f((unsigned short)(u2.y >> 16));
                u32x2 w; w.x = pk2(u0 * (acc[4 * gq] * vg4[gq][0] + bias), u1 * (acc[4 * gq + 1] * vg4[gq][1] + bias)); w.y = pk2(u2f * (acc[4 * gq + 2] * vg4[gq][2] + bias), u3 * (acc[4 * gq + 3] * vg4[gq][3] + bias));
                *(u32x2*)up = w; }
        }
    }
}

#define XB_TMO      128
#define XB_XCNT(j)  (256  + 64 * (j))
#define XB_XSUB(j)  (1280 + 64 * (j))
#define XB_XGEN(j)  (2304 + 64 * (j))
#define XB_TOP      3328
#define XB_TOPGEN   3392
#define XCD_BAR_WORDS 3456
#define XB_SPIN_CAP (1u << 18)
DI unsigned xb_ld(unsigned* p)              { return __hip_atomic_load(p, __ATOMIC_RELAXED, __HIP_MEMORY_SCOPE_AGENT); }
DI unsigned xb_add(unsigned* p, unsigned v) { return __hip_atomic_fetch_add(p, v, __ATOMIC_RELAXED, __HIP_MEMORY_SCOPE_AGENT); }
DI unsigned xb_xcc_id() { return (unsigned)__builtin_amdgcn_s_getreg((3 << 11) | 20) & 0xFu; }
#define XB_SPIN(cond, bar) do { unsigned _sp = 0; while (cond) { __builtin_amdgcn_s_sleep(1); \
    if ((++_sp & 255u) == 0u) { if (xb_ld(&(bar)[XB_TMO])) break; if (_sp > XB_SPIN_CAP) { atomicAdd(&(bar)[XB_TMO], 1u); break; } } } } while (0)
struct XcdBarrier { unsigned* bar; unsigned x; volatile LAS unsigned* st; };
DI XcdBarrier xcd_barrier_post(unsigned* bar, volatile LAS unsigned* st, int tid) {
    XcdBarrier b; b.bar = bar; b.x = xb_xcc_id(); b.st = st;
    if (tid == 0) (void)xb_add(&bar[XB_XCNT(b.x)], 1u);
    return b;
}
DI void xcd_barrier_complete(unsigned* bar, unsigned x, unsigned& nloc, unsigned& nx) {
    const unsigned G = gridDim.x * gridDim.y * gridDim.z;
    unsigned sum, cnt, mine, sp = 0u;
    for (;;) {
        sum = 0u; cnt = 0u; mine = 0u;
#pragma unroll
        for (unsigned j = 0; j < 16; ++j) { const unsigned c = xb_ld(&bar[XB_XCNT(j)]); sum += c; cnt += (c > 0u) ? 1u : 0u; mine = (j == x) ? c : mine; }
        if (sum == G) break;
        __builtin_amdgcn_s_sleep(1);
        if ((++sp & 255u) == 0u) { if (xb_ld(&bar[XB_TMO])) break; if (sp > XB_SPIN_CAP) { atomicAdd(&bar[XB_TMO], 1u); break; } }
    }
    nloc = mine > 0u ? mine : 1u; nx = cnt > 0u ? cnt : 1u;
}
DI void xcd_barrier(const XcdBarrier& b, int tid) {
    asm volatile("s_waitcnt vmcnt(0)" ::: "memory");
    __syncthreads();
    if (tid == 0) {
        unsigned* bar = b.bar;
        __builtin_amdgcn_s_waitcnt(0);
        unsigned nloc = b.st[0], nx = b.st[1];
        if (nloc == 0u) { xcd_barrier_complete(bar, b.x, nloc, nx); b.st[0] = nloc; b.st[1] = nx; }
        const unsigned old = xb_add(&bar[XB_XSUB(b.x)], 1u);
        const unsigned gen = old / nloc;
        if (old + 1u == (gen + 1u) * nloc) {
            __builtin_amdgcn_fence(__ATOMIC_RELEASE, "agent");
            asm volatile("s_waitcnt vmcnt(0)" ::: "memory");
            const unsigned og = xb_add(&bar[XB_TOP], 1u);
            const unsigned tg = og / nx;
            if (og + 1u == (tg + 1u) * nx) xb_add(&bar[XB_TOPGEN], 1u);
            else XB_SPIN(xb_ld(&bar[XB_TOPGEN]) == tg, bar);
            __builtin_amdgcn_fence(__ATOMIC_ACQUIRE, "agent");
            xb_add(&bar[XB_XGEN(b.x)], 1u);
            asm volatile("s_waitcnt vmcnt(0)" ::: "memory");
        } else {
            XB_SPIN(xb_ld(&bar[XB_XGEN(b.x)]) == gen, bar);
            __builtin_amdgcn_fence(__ATOMIC_ACQUIRE, "agent");
            asm volatile("s_waitcnt vmcnt(0)" ::: "memory");
        }
    }
    __syncthreads();
}

__global__ void __launch_bounds__(512, 2) mega_fwd(Params p) {
    extern __shared__ __attribute__((aligned(16))) unsigned char lds_raw[];
    LAS unsigned char* lds = (LAS unsigned char*)lds_raw;
    volatile LAS unsigned* misc = (volatile LAS unsigned*)(lds + LDS_BYTES - 64);
    const int wave_s = __builtin_amdgcn_readfirstlane((int)threadIdx.x >> 6);
    { const int t0 = wave_s * 64 + (int)__lane_id(); if (t0 < 4) misc[t0] = 0u; }
    __syncthreads();
    XcdBarrier bar = xcd_barrier_post((unsigned*)(p.ws + WS_CTL + 65536), misc, wave_s * 64 + (int)__lane_id());
    for (int ph = p.ph_lo; ph < p.ph_hi; ++ph) {
      const int nrep = (ph == p.rep_ph) ? p.rep_n : 1;
      for (int rep = 0; rep < nrep; ++rep) {
        int wv_ = wave_s; asm volatile("" : "+s"(wv_)); int lid_; asm volatile("v_mbcnt_lo_u32_b32 %0, -1, 0\n\tv_mbcnt_hi_u32_b32 %0, -1, %0" : "=&v"(lid_)); int tid = wv_ * 64 + lid_;
        int cb = blockIdx.x; asm volatile("" : "+s"(cb));
        int G = gridDim.x; asm volatile("" : "+s"(G));
        size_t wz = 0; asm volatile("" : "+s"(wz)); unsigned char* ws = p.ws + wz;
        const int lane = tid & 63, wid = __builtin_amdgcn_readfirstlane(tid >> 6);
        const int gw = cb * 8 + wid, ngw = G * 8;
        const bf16_t* XN = (const bf16_t*)(ws + WS_XN);
        const float* mod = (const float*)(ws + WS_MOD);
        float* rssb = (float*)(ws + WS_CTL + WS_RSS); const float* swb = (const float*)(ws + WS_SW);
        const bool tailmode = G >= 224;
        unsigned* tailcnt = (unsigned*)(ws + WS_CTL + 57344);
        if (ph == 0) prep_phase(p, ws, lds, tid, wid, lane, cb, G);
        else if (ph == 1) phase1(p, ws, gw, ngw, lane);
        else {
            const int l = (ph - 2) / 7, r = (ph - 2) % 7;
            if (r == 0 || r == 5) {
                const int f = (r == 5) ? 1 : 0, mi = l * 2 + f, ni = l * 3 + (f ? 2 : 0);
                const char* Wg = (const char*)(ws + WS_W + (size_t)mi * FFN_STRIDE);
                pg8::GemmDesc g0{(const char*)XN, Wg, tailmode ? 32 : 48, 22, 0, 0}, g1{(const char*)XN + (size_t)32 * 256 * D * 2, Wg, tailmode ? 16 : 0, tailmode ? 20 : 0, 32, 0};
                pg8::Sched2 S; S.init(g0, g1, D, G, cb);
                EpiGU E{(bf16_t*)(ws + WS_R + R_HID), rssb + ni * MTOK, swb + mi * 3 * 5632};
                pg8::gemm_phase<EpiGU, pg8::Sched2>(lds, tid, D, S, E);
            } else if (r == 1 || r == 6 || r == 4) {
                const char* A; const char* B; int K, jdx, nl, nj; float w;
                if (r == 4) { jdx = 1; w = 1.f; nl = l; nj = 2; if (l == 0) { A = (const char*)(ws + WS_R + R_AO); B = (const char*)(ws + WS_WO); K = 1024; } else { A = (const char*)(ws + WS_R + R_U); B = (const char*)(ws + WS_WSO); K = 2048; } }
                else { const int f = (r == 6) ? 1 : 0, mi = l * 2 + f; jdx = f ? 2 : 0; w = 0.5f; A = (const char*)(ws + WS_R + R_HID); B = (const char*)(ws + WS_W + (size_t)mi * FFN_STRIDE + FFN_DOWN); K = FH;
                       if (f == 0) { nl = l; nj = 1; } else { nl = l + 1; nj = 0; } }
                pg8::GemmDesc g0{A, B, 48, 4, 0, 0}, g1{nullptr, nullptr, 0, 0, 0, 0};
                pg8::Sched2 S; S.init(g0, g1, K, G, cb);
                const int ffn = (r == 4) ? -1 : l * 2 + ((r == 6) ? 1 : 0);
                EpiRes E{p.out, mod, p.in[8], ws, p.in[0], p.in[1], l, 3 * jdx + 2, nl < 2 ? nl * 3 + nj : -1, (tailmode && ffn >= 0) ? tailcnt + ffn * 256 : nullptr};
                pg8::gemm_phase<EpiRes, pg8::Sched2>(lds, tid, K, S, E);
                if (cb >= 192 && G > 192) {
                    int lid2; asm volatile("v_mbcnt_lo_u32_b32 %0, -1, 0\n\tv_mbcnt_hi_u32_b32 %0, -1, %0" : "=&v"(lid2)); int tid2 = wv_ * 64 + lid2;
                    if (tailmode && ffn >= 0 && cb < 224) {
                        const char* Wg = (const char*)(ws + WS_W + (size_t)ffn * FFN_STRIDE);
                        pg8::GemmDesc t0{(const char*)XN + (size_t)32 * 256 * D * 2, Wg + (size_t)20 * 256 * D * 2, 16, 2, 32, 20}, t1{nullptr, nullptr, 0, 0, 0, 0};
                        pg8::Sched2 ST; ST.init(t0, t1, D, 32, cb - 192);
                        EpiGU EG{(bf16_t*)(ws + WS_R + R_HID), rssb + (l * 3 + ((r == 6) ? 2 : 0)) * MTOK, swb + ffn * 3 * 5632};
                        pg8::gemm_phase<EpiGU, pg8::Sched2>(lds, tid2, D, ST, EG);
                        pg8::Unit tu; ST.next(0, tu);
                        asm volatile("s_waitcnt vmcnt(0)" ::: "memory"); __syncthreads();
                        asm volatile("v_mbcnt_lo_u32_b32 %0, -1, 0\n\tv_mbcnt_hi_u32_b32 %0, -1, %0" : "=&v"(lid2)); tid2 = wv_ * 64 + lid2;
                        if (tid2 == 0) { __builtin_amdgcn_fence(__ATOMIC_RELEASE, "agent"); asm volatile("s_waitcnt vmcnt(0)" ::: "memory");
                                        __hip_atomic_fetch_add(tailcnt + ffn * 256 + (tu.pm - 32) * 16, 1u, __ATOMIC_RELAXED, __HIP_MEMORY_SCOPE_AGENT); }
                        __syncthreads();
                    }
                    const int igw = (cb - 192) * 8 + wid, ingw = (G - 192) * 8;
                    if (ph == 3) { conv_caches(p, ws, (cb - 192) * 512 + tid2, (G - 192) * 512); convert_list(p, ws, lds, (1 << 1) | (1 << 5) | (1 << 9), igw, ingw, wid, lid2); }
                    else if (ph == 6) { mod_gemv(p, ws, lds, 1, 2, igw, ingw, tid2, lid2); convert_list(p, ws, lds, (1 << 2), igw, ingw, wid, lid2); sw_rows(p, ws, (1 << 1), igw, ingw, lid2); }
                    else if (ph == 8) { convert_list(p, ws, lds, (1 << 6) | (1 << 10), igw, ingw, wid, lid2); sw_rows(p, ws, (1 << 2), igw, ingw, lid2); }
                    else if (ph == 10) { convert_list(p, ws, lds, (1 << 3) | (1 << 7) | (1 << 11), igw, ingw, wid, lid2); sw_rows(p, ws, (1 << 6), igw, ingw, lid2); }
                    else if (ph == 13) sw_rows(p, ws, (1 << 3), igw, ingw, lid2);
                }
            } else if (r == 2) {
                if (l == 0) {
                    pg8::GemmDesc g0{(const char*)XN, (const char*)(ws + WS_WQK), 48, 7, 0, 0}, g1{(const char*)(ws + WS_WV), (const char*)XN, 3, 48, 0, 0};
                    pg8::Sched2 S; S.init(g0, g1, D, G, cb);
                    unsigned char* R = ws + WS_R;
                    EpiQKV E{(bf16_t*)(R + R_QNA), (bf16_t*)(R + R_VT), p.out, (const float*)(ws + WS_GTAB), rssb + 1 * MTOK, swb + SW_QKV};
                    pg8::gemm_phase<EpiQKV, pg8::Sched2>(lds, tid, D, S, E);
                } else {
                    pg8::GemmDesc g0{(const char*)XN, (const char*)(ws + WS_WSI), 48, 8, 0, 0}, g1{(const char*)(ws + WS_WSI + (size_t)2048 * D * 2), (const char*)XN, 8, 48, 0, 0};
                    pg8::Sched2 S; S.init(g0, g1, D, G, cb);
                    EpiSGU E{(bf16_t*)(ws + WS_R + R_U), (bf16_t*)(ws + WS_R + R_VTS), (float*)(ws + WS_CTL + 4096), rssb + 4 * MTOK, swb + SW_SGU};
                    pg8::gemm_phase<EpiSGU, pg8::Sched2>(lds, tid, D, S, E);
                }
            } else {
                if (l == 0) attn_phase(p, ws, lds, tid, wid, lane, rep); else spatial_phase(p, ws, lds, tid, wid, lane, cb, G);
            }
        }
        if (ph + 1 < p.ph_hi || rep + 1 < nrep) {
            { XcdBarrier b2 = bar; size_t bz = 0; asm volatile("" : "+s"(bz)); b2.bar = bar.bar + bz; xcd_barrier(b2, tid); }
        }
      }
    }
}

extern "C" void kernel_launch(void* const* d_in, const int* in_sizes, int n_in, void* d_out, int out_size, void* d_ws, size_t ws_size, hipStream_t stream) {
    static int grid = 0;
    if (grid == 0) {
        if (n_in != 27 || ws_size < WS_END) { fprintf(stderr, "kernel_launch: unexpected n_in %d / ws_size %zu\n", n_in, ws_size); grid = -1; return; }
        int dev = 0, cus = 0, per_cu = 0;
        (void)hipGetDevice(&dev);
        (void)hipDeviceGetAttribute(&cus, hipDeviceAttributeMultiprocessorCount, dev);
        if (hipFuncSetAttribute((const void*)mega_fwd, hipFuncAttributeMaxDynamicSharedMemorySize, LDS_BYTES) != hipSuccess) { fprintf(stderr, "kernel_launch: hipFuncSetAttribute failed\n"); grid = -1; return; }
        if (hipOccupancyMaxActiveBlocksPerMultiprocessor(&per_cu, (const void*)mega_fwd, 512, LDS_BYTES) != hipSuccess || per_cu < 1) { fprintf(stderr, "kernel_launch: occupancy query says %d\n", per_cu); grid = -1; (void)hipGetLastError(); return; }
        grid = cus;
    }
    if (grid < 0) return;
    (void)hipMemsetAsync((char*)d_ws + WS_CTL, 0, CTL_BYTES, stream);
    Params p{};
    for (int i = 0; i < 27; ++i) p.in[i] = (const float*)d_in[i];
    p.out = (float*)d_out; p.ws = (unsigned char*)d_ws; p.ph_lo = 0; p.ph_hi = 16; p.rep_ph = -1; p.rep_n = 1;
    void* args[] = {&p};
    hipError_t e = hipLaunchCooperativeKernel((const void*)mega_fwd, dim3(grid), dim3(512), args, LDS_BYTES, stream);
    if (e != hipSuccess) fprintf(stderr, "cooperative launch failed: %s (grid %d)\n", hipGetErrorString(e), grid);
}
```

```cpp
#include <hip/hip_runtime.h>
#include <hip/hip_cooperative_groups.h>
#include <cstdio>
#include <cstdint>
namespace cg = cooperative_groups;

#define LAS __attribute__((address_space(3)))
#define DI __device__ __forceinline__
typedef unsigned short bf16_t;
typedef short bf16x8 __attribute__((ext_vector_type(8)));
typedef float f32x4 __attribute__((ext_vector_type(4)));
typedef float f32x2 __attribute__((ext_vector_type(2)));
typedef float f32x16 __attribute__((ext_vector_type(16)));
typedef unsigned u32x4 __attribute__((ext_vector_type(4)));
typedef unsigned u32x2 __attribute__((ext_vector_type(2)));
typedef __bf16 bf16x2_t __attribute__((ext_vector_type(2)));

constexpr int D = 1024, MTOK = 12288, MP = 8192, FH = 2816, NMOD = 9216;
constexpr float LOG2E = 1.4426950408889634f;
constexpr float EPS = 1e-6f;
constexpr size_t O_NAK = 12582912, O_NAV = 16777216, O_GK = 20971520, O_GV = 22020096;
constexpr size_t MiB = 1u << 20;
constexpr size_t WS_CTL = 0, CTL_BYTES = 704 * 1024;
constexpr size_t WS_RSS = 131072;
constexpr size_t WS_SW = 5 * MiB;
constexpr int SW_QKV = 4 * 3 * 5632, SW_SGU = SW_QKV + 3 * 2560;
constexpr size_t WS_GTAB = 768 * 1024;
constexpr size_t WS_MOD = 448 * 1024;
constexpr size_t WS_KCNA = 2 * MiB, WS_VCNAT = 3 * MiB, WS_KCG = 4 * MiB, WS_VCGT = 4 * MiB + 256 * 1024;
constexpr size_t WS_W = 8 * MiB, FFN_STRIDE = 17301504, FFN_DOWN = 11 * MiB;
constexpr size_t WS_WQK = 74 * MiB, WS_WV = WS_WQK + 3670016, WS_WO = 79 * MiB, WS_WSI = 81 * MiB, WS_WSO = 89 * MiB;
constexpr size_t WS_XN = 96 * MiB;
constexpr size_t WS_R = 120 * MiB;
constexpr size_t R_HID = 0;
constexpr size_t R_QNA = 0, R_KNA = 12 * MiB, R_QG = 24 * MiB, R_KG = 36 * MiB, R_VT = 40 * MiB, R_AO = 58 * MiB;
constexpr size_t R_U = 0, R_VTS = 48 * MiB;
constexpr size_t WS_END = 216 * MiB;
constexpr int LDS_BYTES = 135168;

struct Params { const float* in[27]; float* out; unsigned char* ws; int ph_lo, ph_hi, rep_ph, rep_n; };

DI unsigned pk2(float lo, float hi) { f32x2 v = {lo, hi}; bf16x2_t b = __builtin_convertvector(v, bf16x2_t); return __builtin_bit_cast(unsigned, b); }
DI float bf2f(unsigned short b) { return __builtin_bit_cast(float, (unsigned)b << 16); }
template <int CTRL> DI float dppf(float v) { return __builtin_bit_cast(float, __builtin_amdgcn_update_dpp(0, __builtin_bit_cast(int, v), CTRL, 0xf, 0xf, true)); }
DI float row16_sum(float v) { v += dppf<0xB1>(v); v += dppf<0x4E>(v); v += dppf<0x124>(v); v += dppf<0x128>(v); return v; }
DI float xor16_sum(float v) { const unsigned b = __builtin_bit_cast(unsigned, v); auto r = __builtin_amdgcn_permlane16_swap(b, b, false, false); return __builtin_bit_cast(float, (unsigned)r[0]) + __builtin_bit_cast(float, (unsigned)r[1]); }
DI float xor32_sum(float v) { const unsigned b = __builtin_bit_cast(unsigned, v); auto r = __builtin_amdgcn_permlane32_swap(b, b, false, false); return __builtin_bit_cast(float, (unsigned)r[0]) + __builtin_bit_cast(float, (unsigned)r[1]); }
DI float xor32_max(float v) { const unsigned b = __builtin_bit_cast(unsigned, v); auto r = __builtin_amdgcn_permlane32_swap(b, b, false, false); return fmaxf(__builtin_bit_cast(float, (unsigned)r[0]), __builtin_bit_cast(float, (unsigned)r[1])); }
DI float wave_sum(float v) { return xor32_sum(xor16_sum(row16_sum(v))); }
DI float silu_f(float x) { return x * __builtin_amdgcn_rcpf(1.f + __builtin_amdgcn_exp2f(-x * LOG2E)); }
DI f32x2 gelu_pk(f32x2 v) {
    const f32x2 av = __builtin_elementwise_abs(v), d = av * 0.2316418882f + 1.0f;
    f32x2 t; t.x = __builtin_amdgcn_rcpf(d.x); t.y = __builtin_amdgcn_rcpf(d.y);
    f32x2 q = t * 0.5307027145f + (-0.7265760135f); q = q * t + 0.7107068705f; q = q * t + (-0.142248368f); q = q * t + 0.127414796f; q = q * t;
    const f32x2 s = (v * v) * (-0.72134752044f);
    f32x2 e; e.x = __builtin_amdgcn_exp2f(s.x); e.y = __builtin_amdgcn_exp2f(s.y);
    const f32x2 m = v * (q * e), r = v - m;
    f32x2 o; o.x = v.x < 0.f ? m.x : r.x; o.y = v.y < 0.f ? m.y : r.y; return o;
}
DI f32x4 gelu4(f32x4 v) { f32x2 a = gelu_pk((f32x2){v[0], v[1]}), b = gelu_pk((f32x2){v[2], v[3]}); return (f32x4){a.x, a.y, b.x, b.y}; }

namespace pg8 {
constexpr int BM = 256, BK = 64, HALF = 128, HTB = HALF * BK * 2, NXCD = 8, WGM = 8;
DI int lds_byte(int r, int c) { const int st = (r >> 4) * 2 + (c >> 5), rr = r & 15, cc = c & 31, ob = rr * 64 + cc * 2; return st * 1024 + (ob ^ (((ob >> 9) & 1) << 5)); }
DI void stage_rc(int b, int& R, int& C) { const int st = b / 1024, sb = b % 1024, swz = sb ^ (((sb >> 9) & 1) << 5); R = (st >> 1) * 16 + swz / 64; C = (st & 1) * 32 + (swz % 64) / 2; }
DI int perm32(int rho) { const int n = rho >> 4, i = rho & 15; return 8 * (i >> 2) + 4 * n + (i & 3); }

struct Unit { const char* a; const char* b; int pm, pn, kind; };
struct GemmDesc { const char* A; const char* B; int nM, nN, pmoff, pnoff; };
struct Sched2 {
    GemmDesc g0, g1; int nwg0, nwg, G, c; size_t tstep;
    DI void init(const GemmDesc& a, const GemmDesc& b, int K, int G_, int c_) { g0 = a; g1 = b; nwg0 = a.nM * a.nN; nwg = nwg0 + b.nM * b.nN; G = G_; c = c_; tstep = (size_t)BM * K * 2; }
    DI bool next(int i, Unit& u) const {
        const long L = (long)i * G + c; if (L >= nwg) return false;
        int wgid = (int)L;
        if ((G & 7) == 0) { const int q = nwg / NXCD, r = nwg % NXCD, xcd = wgid % NXCD, off = wgid / NXCD; wgid = (xcd < r ? xcd * (q + 1) : r * (q + 1) + (xcd - r) * q) + off; }
        const bool k1 = wgid >= nwg0; if (k1) wgid -= nwg0;
        const int nM = k1 ? g1.nM : g0.nM, nN = k1 ? g1.nN : g0.nN;
        const int nig = WGM * nN, gid = wgid / nig, fm = gid * WGM, gsz = (nM - fm) < WGM ? (nM - fm) : WGM;
        const int lpm = fm + ((wgid % nig) % gsz), lpn = (wgid % nig) / gsz; u.kind = k1 ? 1 : 0;
        u.a = (k1 ? g1.A : g0.A) + (size_t)lpm * tstep; u.b = (k1 ? g1.B : g0.B) + (size_t)lpn * tstep;
        u.pm = lpm + (k1 ? g1.pmoff : g0.pmoff); u.pn = lpn + (k1 ? g1.pnoff : g0.pnoff);
        return true;
    }
};

template <class Epi, class Sched>
DI void gemm_phase(LAS unsigned char* lds, const int tid, const int K, const Sched& S, const Epi& E) {
    const int wid = __builtin_amdgcn_readfirstlane(tid >> 6), lane = tid & 63, wr = wid >> 2, wc = wid & 3, fr = lane & 15, fq = lane >> 4;
    const int nt = K / BK;
    unsigned voffA[2], voffB[2];
#pragma unroll
    for (int i = 0; i < 2; ++i) { int R, C; stage_rc(tid * 16 + i * 8192, R, C); const int Rb = Epi::PERM ? ((R & ~31) + perm32(R & 31)) : R;
        voffA[i] = (unsigned)(R * K + C) * 2u; voffB[i] = (unsigned)(Rb * K + C) * 2u; }
    const size_t kstep = (size_t)(BK * 2);
    const size_t hstep = (size_t)HALF * K * 2;
    const unsigned ldsw = (unsigned)wid * 1024u;
    const int aoff = lds_byte(wr * 64 + fr, fq * 8), boff = lds_byte(wc * 32 + fr, fq * 8);
#define PG8_SA(b, h) (((b) * 2 + (h)) * HTB)
#define PG8_SB(b, h) ((4 + (b) * 2 + (h)) * HTB)
#define PG8_STAGE(bufoff, gbase, voff) do { _Pragma("unroll") for (int _i = 0; _i < 2; ++_i) \
        __builtin_amdgcn_global_load_lds((const unsigned*)((const char*)(gbase) + (voff)[_i]), (LAS unsigned*)(lds + (bufoff) + ldsw + _i * 8192), 16, 0, 0); } while (0)
#define PG8_LDA(dst, b, h) do { _Pragma("unroll") for (int m = 0; m < 4; ++m) _Pragma("unroll") for (int k = 0; k < 2; ++k) dst[m][k] = *(const LAS bf16x8*)(lds + PG8_SA(b, h) + aoff + m * 2048 + k * 1024); } while (0)
#define PG8_LDB(dst, b, h) do { _Pragma("unroll") for (int n = 0; n < 2; ++n) _Pragma("unroll") for (int k = 0; k < 2; ++k) dst[n][k] = *(const LAS bf16x8*)(lds + PG8_SB(b, h) + boff + n * 2048 + k * 1024); } while (0)
#define PG8_MMA(ai, bj, At, Bt) do { __builtin_amdgcn_s_setprio(1); _Pragma("unroll") for (int m = 0; m < 4; ++m) _Pragma("unroll") for (int n = 0; n < 2; ++n) _Pragma("unroll") for (int k = 0; k < 2; ++k) \
        acc[ai][bj][m][n] = __builtin_amdgcn_mfma_f32_16x16x32_bf16(Bt[n][k], At[m][k], acc[ai][bj][m][n], 0, 0, 0); __builtin_amdgcn_s_setprio(0); } while (0)
#define PG8_WAIT_V(n) asm volatile("s_waitcnt vmcnt(" #n ")" ::: "memory")
#define PG8_WAIT_L(n) asm volatile("s_waitcnt lgkmcnt(" #n ")" ::: "memory")
#define PG8_BAR __builtin_amdgcn_s_barrier()
#define PG8_SCHED __builtin_amdgcn_sched_barrier(0)
    Unit cur, nxt; int ui = 0;
    if (!S.next(0, cur)) return;
    f32x4 acc[2][2][4][2];
#pragma unroll
    for (int a = 0; a < 2; ++a)
#pragma unroll
        for (int b = 0; b < 2; ++b)
#pragma unroll
            for (int m = 0; m < 4; ++m)
#pragma unroll
                for (int n = 0; n < 2; ++n) acc[a][b][m][n] = (f32x4){0.f, 0.f, 0.f, 0.f};
    bf16x8 At[4][2], B0[2][2], B1[2][2];
    const char* cA = cur.a; const char* cB = cur.b;
    PG8_STAGE(PG8_SB(0, 0), cB, voffB); PG8_STAGE(PG8_SB(0, 1), cB + hstep, voffB); PG8_STAGE(PG8_SA(0, 0), cA, voffA); PG8_STAGE(PG8_SA(0, 1), cA + hstep, voffA);
    if (wr == 1) PG8_BAR;
    PG8_WAIT_V(2); PG8_BAR;
    PG8_STAGE(PG8_SB(1, 0), cB + kstep, voffB); PG8_STAGE(PG8_SA(1, 0), cA + kstep, voffA); PG8_STAGE(PG8_SB(1, 1), cB + hstep + kstep, voffB);
    PG8_WAIT_V(6); PG8_BAR;
    for (;;) {
        const bool has_next = S.next(ui + 1, nxt);
        const char* nA = has_next ? nxt.a : cA; const char* nB = has_next ? nxt.b : cB;
        for (int t = 0; t < nt; t += 2) {
            if constexpr (Epi::KWAIT) { if (t == nt - 6 && E.need_wait(cur)) E.do_wait(cur, wid); }
            const bool last = (t == nt - 2);
            const char* a1 = cA + (size_t)(t + 1) * kstep;
            const char* a2 = last ? nA : cA + (size_t)(t + 2) * kstep; const char* b2 = last ? nB : cB + (size_t)(t + 2) * kstep;
            const char* a3 = a2 + kstep; const char* b3 = b2 + kstep;
            PG8_LDB(B0, 0, 0); PG8_LDB(B1, 0, 1); PG8_SCHED; PG8_LDA(At, 0, 0); PG8_STAGE(PG8_SA(1, 1), a1 + hstep, voffA);
            PG8_WAIT_V(8); PG8_WAIT_L(0); PG8_BAR; PG8_MMA(0, 0, At, B0); PG8_MMA(0, 1, At, B1); PG8_BAR; PG8_SCHED;
            PG8_LDA(At, 0, 1); PG8_STAGE(PG8_SB(0, 0), b2, voffB); PG8_STAGE(PG8_SB(0, 1), b2 + hstep, voffB); PG8_STAGE(PG8_SA(0, 0), a2, voffA);
            PG8_WAIT_V(8); PG8_WAIT_L(0); PG8_BAR; PG8_MMA(1, 0, At, B0); PG8_MMA(1, 1, At, B1); PG8_BAR; PG8_SCHED;
            PG8_LDB(B0, 1, 0); PG8_LDB(B1, 1, 1); PG8_SCHED; PG8_LDA(At, 1, 0); PG8_STAGE(PG8_SA(0, 1), a2 + hstep, voffA);
            PG8_WAIT_V(8); PG8_WAIT_L(0); PG8_BAR; PG8_MMA(0, 0, At, B0); PG8_MMA(0, 1, At, B1); PG8_BAR; PG8_SCHED;
            PG8_LDA(At, 1, 1); PG8_STAGE(PG8_SB(1, 0), b3, voffB); PG8_STAGE(PG8_SB(1, 1), b3 + hstep, voffB); PG8_STAGE(PG8_SA(1, 0), a3, voffA);
            PG8_WAIT_V(8); PG8_WAIT_L(0); PG8_BAR; PG8_MMA(1, 0, At, B0); PG8_MMA(1, 1, At, B1); PG8_BAR; PG8_SCHED;
        }
        if (wr == 0) PG8_BAR;
        E(acc, cur, wr, wc, fr, fq);
        if (!has_next) break;
#pragma unroll
        for (int a = 0; a < 2; ++a)
#pragma unroll
            for (int b = 0; b < 2; ++b)
#pragma unroll
                for (int m = 0; m < 4; ++m)
#pragma unroll
                    for (int n = 0; n < 2; ++n) acc[a][b][m][n] = (f32x4){0.f, 0.f, 0.f, 0.f};
        cur = nxt; cA = nA; cB = nB; ++ui;
        if (wr == 1) PG8_BAR;
    }
    PG8_WAIT_V(0);
    PG8_BAR;
#undef PG8_SA
#undef PG8_SB
#undef PG8_STAGE
#undef PG8_LDA
#undef PG8_LDB
#undef PG8_MMA
#undef PG8_WAIT_V
#undef PG8_WAIT_L
#undef PG8_BAR
#undef PG8_SCHED
}
}

struct EpiGU {
    static constexpr bool PERM = true, KWAIT = false; bf16_t* H; const float* rss; const float* sw;
    DI void operator()(const f32x4 (&acc)[2][2][4][2], const pg8::Unit& u, int wr, int wc, int fr, int fq) const {
        asm volatile("" : "+v"(fr), "+v"(fq));
        const int row0 = u.pm * 256 + wr * 64 + fr, col0 = u.pn * 128 + wc * 32 + 8 * fq;
        const int cond = u.pm < 32 ? 0 : 1 + ((u.pm - 32) >> 3);
        const float* swp = sw + cond * 5632 + u.pn * 256 + wc * 32 + 8 * fq;
        const f32x4 sg0 = *(const f32x4*)(swp), sg1 = *(const f32x4*)(swp + 4), su0 = *(const f32x4*)(swp + 128), su1 = *(const f32x4*)(swp + 132);
        float rs8[8];
#pragma unroll
        for (int it = 0; it < 8; ++it) rs8[it] = rss[row0 + (it >> 2) * 128 + (it & 3) * 16];
#pragma unroll
        for (int ai = 0; ai < 2; ++ai)
#pragma unroll
            for (int m = 0; m < 4; ++m) {
                const int row = row0 + ai * 128 + m * 16;
                const float rstd = rsqrtf(rs8[ai * 4 + m] * (1.f / D) + EPS);
                bf16_t* rowp = H + (size_t)row * FH + col0;
                const f32x4 g0 = acc[ai][0][m][0] * rstd + sg0, g1 = acc[ai][0][m][1] * rstd + sg1, u0 = acc[ai][1][m][0] * rstd + su0, u1 = acc[ai][1][m][1] * rstd + su1;
                u32x4 w;
                w.x = pk2(silu_f(g0[0]) * u0[0], silu_f(g0[1]) * u0[1]); w.y = pk2(silu_f(g0[2]) * u0[2], silu_f(g0[3]) * u0[3]);
                w.z = pk2(silu_f(g1[0]) * u1[0], silu_f(g1[1]) * u1[1]); w.w = pk2(silu_f(g1[2]) * u1[2], silu_f(g1[3]) * u1[3]);
                *(u32x4*)rowp = w;
                __builtin_amdgcn_sched_barrier(0);
            }
    }
};
struct EpiRes {
    static constexpr bool PERM = false, KWAIT = true; float* out; const float* mod; const float* normg; unsigned char* ws; const float* xp; const float* xs; int l, gidx, ni; unsigned* tcnt;
    DI bool need_wait(const pg8::Unit& u) const { return tcnt != nullptr && u.pm >= 32; }
    DI void do_wait(const pg8::Unit& u, int wid) const {
        if (wid == 0) { unsigned sp = 0; while ((unsigned)__builtin_amdgcn_readfirstlane(__hip_atomic_load(tcnt + (u.pm - 32) * 16, __ATOMIC_RELAXED, __HIP_MEMORY_SCOPE_AGENT)) < 2u) { __builtin_amdgcn_s_sleep(2); if (++sp > (1u << 22)) break; }
            __builtin_amdgcn_fence(__ATOMIC_ACQUIRE, "agent"); asm volatile("s_waitcnt vmcnt(0)" ::: "memory"); }
        asm volatile("" ::: "memory"); __builtin_amdgcn_s_barrier(); asm volatile("" ::: "memory");
    }
    DI void operator()(const f32x4 (&acc)[2][2][4][2], const pg8::Unit& u, int wr, int wc, int fr, int fq) const {
        asm volatile("" : "+v"(fr), "+v"(fq));
        const int cond = u.pm < 32 ? 0 : 1 + ((u.pm - 32) >> 3);
        const float* gate = mod + (size_t)l * 3 * NMOD + (cond * 9 + gidx) * D;
        const float w = gidx == 5 ? 1.f : 0.5f;
        const bool nn = ni >= 0; const int nl = nn ? ni / 3 : 0, nj = nn ? ni - 3 * nl : 0;
        const float* ng = normg + (nn ? ni : 0) * D; const float* nscale = mod + (size_t)nl * 3 * NMOD + (cond * 9 + 3 * nj + 1) * D;
        float* rss = (float*)(ws + WS_CTL + WS_RSS) + (nn ? ni : 0) * MTOK; bf16_t* xn = (bf16_t*)(ws + WS_XN);
        const int col0 = u.pn * 256 + wc * 32 + 4 * fq;
        f32x4 gv[2][2], gs[2][2];
#pragma unroll
        for (int bj = 0; bj < 2; ++bj)
#pragma unroll
            for (int n = 0; n < 2; ++n) { const int c = col0 + bj * 128 + n * 16; gv[bj][n] = *(const f32x4*)(gate + c) * w;
                gs[bj][n] = *(const f32x4*)(ng + c) * (*(const f32x4*)(nscale + c) + 1.f); }
        const int rowb = u.pm * 256 + wr * 64 + fr;
        const float* rb = (l == 0 && gidx == 2) ? (u.pm < 32 ? xp : xs - (size_t)MP * D) : out;
        f32x4 bn[2][2];
#pragma unroll
        for (int bj = 0; bj < 2; ++bj)
#pragma unroll
            for (int n = 0; n < 2; ++n) bn[bj][n] = *(const f32x4*)(rb + (size_t)rowb * D + col0 + bj * 128 + n * 16);
#pragma unroll
        for (int it = 0; it < 8; ++it) {
            const int ai = it >> 2, m = it & 3;
            const int row = rowb + ai * 128 + m * 16;
            float* op = out + (size_t)row * D; float ss = 0.f;
            f32x4 bc[2][2];
#pragma unroll
            for (int bj = 0; bj < 2; ++bj)
#pragma unroll
                for (int n = 0; n < 2; ++n) bc[bj][n] = bn[bj][n];
            if (it < 7) { const int rown = rowb + ((it + 1) >> 2) * 128 + ((it + 1) & 3) * 16;
#pragma unroll
                for (int bj = 0; bj < 2; ++bj)
#pragma unroll
                    for (int n = 0; n < 2; ++n) bn[bj][n] = *(const f32x4*)(rb + (size_t)rown * D + col0 + bj * 128 + n * 16); }
#pragma unroll
            for (int bj = 0; bj < 2; ++bj)
#pragma unroll
                for (int n = 0; n < 2; ++n) { const int c = col0 + bj * 128 + n * 16; const f32x4 o = bc[bj][n] + gv[bj][n] * acc[ai][bj][m][n]; *(f32x4*)(op + c) = o;
                    if (nn) { ss += (o[0] * o[0] + o[1] * o[1]) + (o[2] * o[2] + o[3] * o[3]); const f32x4 y = o * gs[bj][n]; u32x2 pw; pw.x = pk2(y[0], y[1]); pw.y = pk2(y[2], y[3]); *(u32x2*)(xn + (size_t)row * D + c) = pw; } }
            if (nn) { ss = xor32_sum(xor16_sum(ss)); if (fq == 0) atomicAdd(rss + row, ss); }
            __builtin_amdgcn_sched_barrier(0);
        }
    }
};
struct EpiQKV {
    static constexpr bool PERM = false, KWAIT = false;
    bf16_t *qk, *vt; float* out; const float* gtab; const float* rss; const float* sw;
    DI void operator()(const f32x4 (&acc)[2][2][4][2], const pg8::Unit& u, int wr, int wc, int fr, int fq) const {
        asm volatile("" : "+v"(fr), "+v"(fq));
        if (u.kind == 0) {
            const int slot = u.pn * 4 + wc;
            if (slot >= 26) return;
            const int type = slot < 8 ? 0 : slot < 16 ? 1 : slot < 24 ? 2 : 3;
            const int h = slot - (type == 0 ? 0 : type == 1 ? 8 : type == 2 ? 16 : 24);
            const float* g = gtab + type * 64;
            bf16_t* dst = qk + (size_t)slot * MTOK * 64;
            const float qs = (type == 0 || type == 2) ? 0.125f * LOG2E : 1.f;
            const bool rope = (type >= 2) && (u.pm >= 32);
            f32x4 gv[2][2];
#pragma unroll
            for (int bj = 0; bj < 2; ++bj)
#pragma unroll
                for (int n = 0; n < 2; ++n) gv[bj][n] = *(const f32x4*)(g + 32 * bj + 16 * n + 4 * fq);
            const int cond = u.pm < 32 ? 0 : 1 + ((u.pm - 32) >> 3);
            f32x4 sv[2][2];
#pragma unroll
            for (int bj = 0; bj < 2; ++bj)
#pragma unroll
                for (int n = 0; n < 2; ++n) sv[bj][n] = *(const f32x4*)(sw + cond * 2560 + u.pn * 256 + bj * 128 + wc * 32 + 16 * n + 4 * fq);
            float rs8[8];
#pragma unroll
            for (int it = 0; it < 8; ++it) rs8[it] = rss[u.pm * 256 + (it >> 2) * 128 + wr * 64 + (it & 3) * 16 + fr];
            float freq[4];
#pragma unroll
            for (int i = 0; i < 4; ++i) freq[i] = __builtin_amdgcn_exp2f(-(float)(4 * fq + i) * (0.0625f * 13.287712379549449f));
#pragma unroll
            for (int ai = 0; ai < 2; ++ai)
#pragma unroll
                for (int m = 0; m < 4; ++m) {
                    const int row = u.pm * 256 + ai * 128 + wr * 64 + m * 16 + fr;
                    f32x4 y[2][2]; float ss = 0.f; const float rin = rsqrtf(rs8[ai * 4 + m] * (1.f / D) + EPS);
#pragma unroll
                    for (int bj = 0; bj < 2; ++bj)
#pragma unroll
                        for (int n = 0; n < 2; ++n) { y[bj][n] = acc[ai][bj][m][n] * rin + sv[bj][n]; const f32x4 x = y[bj][n]; ss += (x[0] * x[0] + x[1] * x[1]) + (x[2] * x[2] + x[3] * x[3]); }
                    ss = xor32_sum(xor16_sum(ss));
                    const float rstd = rsqrtf(ss * (1.f / 64.f) + EPS);
#pragma unroll
                    for (int bj = 0; bj < 2; ++bj)
#pragma unroll
                        for (int n = 0; n < 2; ++n) y[bj][n] = y[bj][n] * rstd * gv[bj][n];
                    if (rope) {
                        const int t = (row - MP) & 2047;
#pragma unroll
                        for (int bj = 0; bj < 2; ++bj) {
                            const float pos = (float)(bj == 0 ? (t >> 6) : (t & 63));
#pragma unroll
                            for (int i = 0; i < 4; ++i) {
                                const float ang = pos * freq[i]; const float sn = __sinf(ang), cs = __cosf(ang);
                                const float x1 = y[bj][0][i], x2 = y[bj][1][i];
                                y[bj][0][i] = x1 * cs - x2 * sn; y[bj][1][i] = x1 * sn + x2 * cs;
                            }
                        }
                    }
                    if (u.pm < 32 && (type == 1 || type == 3)) {
                        const size_t oo = (type == 1 ? O_NAK + (size_t)row * 512 : O_GK + (size_t)row * 128) + h * 64;
                        float* o = out + oo;
#pragma unroll
                        for (int bj = 0; bj < 2; ++bj)
#pragma unroll
                            for (int n = 0; n < 2; ++n) *(f32x4*)(o + 32 * bj + 16 * n + 4 * fq) = y[bj][n];
                    }
                    bf16_t* dp = dst + (size_t)row * 64 + 4 * fq;
#pragma unroll
                    for (int bj = 0; bj < 2; ++bj)
#pragma unroll
                        for (int n = 0; n < 2; ++n) { const f32x4 v = y[bj][n] * qs; u32x2 w; w.x = pk2(v[0], v[1]); w.y = pk2(v[2], v[3]); *(u32x2*)(dp + 32 * bj + 16 * n) = w; }
                    __builtin_amdgcn_sched_barrier(0);
                }
        } else {
            const int condt = u.pn < 32 ? 0 : 1 + ((u.pn - 32) >> 3);
            f32x4 rt[2][2]; float sw8[8];
#pragma unroll
            for (int bj = 0; bj < 2; ++bj)
#pragma unroll
                for (int n = 0; n < 2; ++n) { const f32x4 q4 = *(const f32x4*)(rss + u.pn * 256 + bj * 128 + wc * 32 + 16 * n + 4 * fq);
#pragma unroll
                    for (int i = 0; i < 4; ++i) rt[bj][n][i] = rsqrtf(q4[i] * (1.f / D) + EPS); }
#pragma unroll
            for (int it = 0; it < 8; ++it) { const int dv = u.pm * 256 + (it >> 2) * 128 + wr * 64 + (it & 3) * 16 + fr; sw8[it] = sw[condt * 2560 + 1792 + (dv < 768 ? dv : 0)]; }
#pragma unroll
            for (int ai = 0; ai < 2; ++ai)
#pragma unroll
                for (int m = 0; m < 4; ++m) {
                    const int dv = u.pm * 256 + ai * 128 + wr * 64 + m * 16 + fr;
                    if (dv < 640) {
                        const float swv = sw8[ai * 4 + m];
#pragma unroll
                        for (int bj = 0; bj < 2; ++bj)
#pragma unroll
                            for (int n = 0; n < 2; ++n) {
                                const int tok0 = u.pn * 256 + bj * 128 + wc * 32 + 16 * n + 4 * fq;
                                const f32x4 v = acc[ai][bj][m][n] * rt[bj][n] + swv;
                                u32x2 w; w.x = pk2(v[0], v[1]); w.y = pk2(v[2], v[3]);
                                *(u32x2*)(vt + (size_t)dv * MTOK + tok0) = w;
                                if (u.pn < 32) {
                                    if (dv < 512) { float* o = out + O_NAV + (size_t)tok0 * 512 + dv; o[0] = v[0]; o[512] = v[1]; o[1024] = v[2]; o[1536] = v[3]; }
                                    else { float* o = out + O_GV + (size_t)tok0 * 128 + (dv - 512); o[0] = v[0]; o[128] = v[1]; o[256] = v[2]; o[384] = v[3]; }
                                }
                            }
                    }
                    __builtin_amdgcn_sched_barrier(0);
                }
        }
    }
};
struct EpiSGU {
    static constexpr bool PERM = true, KWAIT = false; bf16_t* U; bf16_t* VTS; float* rowss; const float* rss; const float* sw;
    DI void operator()(const f32x4 (&acc)[2][2][4][2], const pg8::Unit& u, int wr, int wc, int fr, int fq) const {
        asm volatile("" : "+v"(fr), "+v"(fq));
        const int r0 = u.pm * 256 + wr * 64 + fr, c0 = u.pn * 256 + wc * 32 + 8 * fq;
        bf16_t* base = u.kind ? VTS : U; const size_t ld = u.kind ? (size_t)MTOK : (size_t)2048;
        const int condc = u.kind ? (u.pn < 32 ? 0 : 1 + ((u.pn - 32) >> 3)) : (u.pm < 32 ? 0 : 1 + ((u.pm - 32) >> 3));
        f32x4 cs[2][2];
#pragma unroll
        for (int bj = 0; bj < 2; ++bj)
#pragma unroll
            for (int n = 0; n < 2; ++n) {
                if (u.kind == 0) cs[bj][n] = *(const f32x4*)(sw + condc * 4096 + c0 + bj * 128 + 4 * n);
                else { const f32x4 q4 = *(const f32x4*)(rss + c0 + bj * 128 + 4 * n);
#pragma unroll
                    for (int i = 0; i < 4; ++i) cs[bj][n][i] = rsqrtf(q4[i] * (1.f / D) + EPS); }
            }
        f32x4 sq[2][2];
#pragma unroll
        for (int bj = 0; bj < 2; ++bj)
#pragma unroll
            for (int n = 0; n < 2; ++n) sq[bj][n] = (f32x4){0.f, 0.f, 0.f, 0.f};
        float rs8[8];
#pragma unroll
        for (int it = 0; it < 8; ++it) { const int row = r0 + (it >> 2) * 128 + (it & 3) * 16; rs8[it] = u.kind ? sw[condc * 4096 + 2048 + row] : rss[row]; }
#pragma unroll
        for (int ai = 0; ai < 2; ++ai)
#pragma unroll
            for (int m = 0; m < 4; ++m) {
                const int row = r0 + ai * 128 + m * 16;
                const float rsc = u.kind ? rs8[ai * 4 + m] : rsqrtf(rs8[ai * 4 + m] * (1.f / D) + EPS);
                bf16_t* rowp = base + (size_t)row * ld + c0;
#pragma unroll
                for (int bj = 0; bj < 2; ++bj) {
                    const f32x4 x0 = u.kind ? acc[ai][bj][m][0] * cs[bj][0] + rsc : acc[ai][bj][m][0] * rsc + cs[bj][0];
                    const f32x4 x1 = u.kind ? acc[ai][bj][m][1] * cs[bj][1] + rsc : acc[ai][bj][m][1] * rsc + cs[bj][1];
                    const f32x4 a = gelu4(x0), b = gelu4(x1);
                    sq[bj][0] += a * a; sq[bj][1] += b * b;
                    u32x4 w; w.x = pk2(a[0], a[1]); w.y = pk2(a[2], a[3]); w.z = pk2(b[0], b[1]); w.w = pk2(b[2], b[3]); *(u32x4*)(rowp + bj * 128) = w; }
                __builtin_amdgcn_sched_barrier(0);
            }
        if (u.kind) {
#pragma unroll
            for (int bj = 0; bj < 2; ++bj)
#pragma unroll
                for (int n = 0; n < 2; ++n)
#pragma unroll
                    for (int i = 0; i < 4; ++i) {
                        float s = sq[bj][n][i];
                        s = row16_sum(s);
                        if (fr == 0) atomicAdd(rowss + c0 + bj * 128 + 4 * n + i, s);
                    }
        }
    }
};

struct TItem { const float* src; bf16_t* dst0; bf16_t* dst1; int ldw, Kd; };
DI void titem_load(const TItem& t, int lane, float (&v)[64]) {
#pragma unroll
    for (int i = 0; i < 64; ++i) v[i] = __builtin_nontemporal_load(t.src + (size_t)i * t.ldw + lane);
}
DI void titem_finish(const TItem& t, LAS float* scr, int lane, const float (&v)[64]) {
#pragma unroll
    for (int i = 0; i < 64; ++i) scr[i * 65 + lane] = v[i];
    asm volatile("s_waitcnt lgkmcnt(0)" ::: "memory");
    const int c = lane & 7;
#pragma unroll
    for (int j = 0; j < 8; ++j) { const int n = (lane >> 3) + 8 * j; const LAS float* s = scr + (8 * c) * 65 + n;
        u32x4 o; o.x = pk2(s[0 * 65], s[1 * 65]); o.y = pk2(s[2 * 65], s[3 * 65]); o.z = pk2(s[4 * 65], s[5 * 65]); o.w = pk2(s[6 * 65], s[7 * 65]);
        bf16_t* d = (j < 4 ? t.dst0 + (size_t)n * t.Kd : t.dst1 + (size_t)(n - 32) * t.Kd) + 8 * c;
        *(u32x4*)d = o; }
    asm volatile("s_waitcnt lgkmcnt(0)" ::: "memory");
}
DI void convert_list(const Params& p, unsigned char* ws, LAS unsigned char* lds, int mask, int gw, int ngw, int wid, int lane) {
    LAS float* scr = (LAS float*)(lds + wid * 16640);
    int NIT = 0;
#pragma unroll
    for (int m = 0; m < 12; ++m) { const int cnt = m < 4 ? 1408 : m < 8 ? 704 : m == 8 ? 576 : m == 9 ? 256 : m == 10 ? 1024 : 512; if ((mask >> m) & 1) NIT += cnt; }
    auto decode = [&](int a, TItem& t) {
        int mm = 0, r = a; bool found = false;
#pragma unroll
        for (int m = 0; m < 12; ++m) { const int cnt = m < 4 ? 1408 : m < 8 ? 704 : m == 8 ? 576 : m == 9 ? 256 : m == 10 ? 1024 : 512;
            if (!found && ((mask >> m) & 1)) { if (r < cnt) { mm = m; found = true; } else r -= cnt; } }
        const float* W; bf16_t* WT; int ldw, Kd, k0, n0, drow0, drow1;
        if (mm < 4) { const int mi = mm, l = mi >> 1, f = mi & 1;
            W = (f ? p.in[13] : p.in[11]) + (size_t)l * D * 5632; const int kb = r / 88, nb = r % 88; n0 = nb * 64; k0 = kb * 64; ldw = 5632; Kd = D;
            drow0 = n0 < FH ? (n0 >> 7) * 256 + (n0 & 127) : ((n0 - FH) >> 7) * 256 + 128 + ((n0 - FH) & 127); drow1 = drow0 + 32;
            WT = (bf16_t*)(ws + WS_W + (size_t)mi * FFN_STRIDE); }
        else if (mm < 8) { const int mi = mm - 4, l = mi >> 1, f = mi & 1;
            W = (f ? p.in[14] : p.in[12]) + (size_t)l * FH * D; const int kb = r / 16, nb = r % 16; n0 = nb * 64; k0 = kb * 64; ldw = D; Kd = FH; drow0 = n0; drow1 = n0 + 32;
            WT = (bf16_t*)(ws + WS_W + (size_t)mi * FFN_STRIDE + FFN_DOWN); }
        else if (mm == 8) { const int kb = r / 36, slot = r % 36; n0 = slot * 64; k0 = kb * 64; ldw = 2304; Kd = D; W = p.in[15];
            if (slot >= 16 && slot < 24) { WT = (bf16_t*)(ws + WS_WV); drow0 = (slot - 16) * 64; drow1 = drow0 + 32; }
            else if (slot >= 34) { WT = (bf16_t*)(ws + WS_WV); drow0 = 512 + (slot - 34) * 64; drow1 = drow0 + 32; }
            else { const int q = slot < 16 ? slot : slot - 8; WT = (bf16_t*)(ws + WS_WQK); drow0 = (q >> 2) * 256 + 32 * (q & 3); drow1 = drow0 + 128; } }
        else if (mm == 9) { const int kb = r / 16, nb = r % 16; n0 = nb * 64; k0 = kb * 64; ldw = D; Kd = D; W = p.in[16]; WT = (bf16_t*)(ws + WS_WO); drow0 = n0; drow1 = n0 + 32; }
        else if (mm == 10) { const int kb = r / 64, nb = r % 64; n0 = nb * 64; k0 = kb * 64; ldw = 4096; Kd = D; W = p.in[22]; WT = (bf16_t*)(ws + WS_WSI); drow0 = n0; drow1 = n0 + 32; }
        else { const int kb = r / 16, nb = r % 16; n0 = nb * 64; k0 = kb * 64; ldw = D; Kd = 2048; W = p.in[26]; WT = (bf16_t*)(ws + WS_WSO); drow0 = n0; drow1 = n0 + 32; }
        t.src = W + (size_t)k0 * ldw + n0; t.dst0 = WT + (size_t)drow0 * Kd + k0; t.dst1 = WT + (size_t)drow1 * Kd + k0; t.ldw = ldw; t.Kd = Kd;
    };
    for (int it = gw; it < NIT; it += ngw) { TItem cur; float vc[64]; decode(it, cur); titem_load(cur, lane, vc); titem_finish(cur, scr, lane, vc); }
}
DI void mod_gemv(const Params& p, unsigned char* ws, LAS unsigned char* lds, int l_lo, int l_hi, int gw, int ngw, int tid, int lane) {
    LAS float* silu = (LAS float*)lds;
    for (int i = tid; i < 3072; i += 512) { const int ci = i >> 10, k = i & 1023; const float x = ci == 0 ? p.in[7][k] : p.in[6][(ci - 1) * D + k]; silu[i] = x / (1.f + __expf(-x)); }
    __syncthreads();
    float* mod = (float*)(ws + WS_MOD);
    const int ntask = (l_hi - l_lo) * 4608;
    for (int id = gw; id < ntask; id += ngw) {
        const int l = l_lo + id / 4608, r = id % 4608, kc = r / 144, st = r - kc * 144, n0 = st * 64, k0 = kc * 32;
        const float* w = p.in[9] + (size_t)l * D * NMOD + (size_t)k0 * NMOD + n0 + lane;
        float wv[32];
#pragma unroll
        for (int kk = 0; kk < 32; ++kk) wv[kk] = __builtin_nontemporal_load(w + (size_t)kk * NMOD);
        float a0 = 0.f, a1 = 0.f, a2 = 0.f;
#pragma unroll
        for (int kk = 0; kk < 32; ++kk) { a0 += silu[k0 + kk] * wv[kk]; a1 += silu[1024 + k0 + kk] * wv[kk]; a2 += silu[2048 + k0 + kk] * wv[kk]; }
        if (kc == 0) { const float bb = p.in[10][l * NMOD + n0 + lane]; a0 += bb; a1 += bb; a2 += bb; }
        atomicAdd(mod + (size_t)(l * 3 + 0) * NMOD + n0 + lane, a0); atomicAdd(mod + (size_t)(l * 3 + 1) * NMOD + n0 + lane, a1); atomicAdd(mod + (size_t)(l * 3 + 2) * NMOD + n0 + lane, a2);
    }
    __syncthreads();
}
DI void conv_caches(const Params& p, unsigned char* ws, int gt, int nth) {
    bf16_t* kcna = (bf16_t*)(ws + WS_KCNA); bf16_t* vcnat = (bf16_t*)(ws + WS_VCNAT); bf16_t* kcg = (bf16_t*)(ws + WS_KCG); bf16_t* vcgt = (bf16_t*)(ws + WS_VCGT);
    for (int i = gt; i < 524288; i += nth) {
        { const int d = i & 63, l = (i >> 6) & 511, h = (i >> 15) & 7, b = i >> 18; kcna[i] = (bf16_t)pk2(p.in[2][((size_t)(b * 512 + l) * 8 + h) * 64 + d], 0.f); }
        { const int l = i & 511, d = (i >> 9) & 63, h = (i >> 15) & 7, b = i >> 18; vcnat[i] = (bf16_t)pk2(p.in[3][((size_t)(b * 512 + l) * 8 + h) * 64 + d], 0.f); }
    }
    for (int i = gt; i < 131072; i += nth) {
        { const int d = i & 63, l = (i >> 6) & 511, kv = (i >> 15) & 1, b = i >> 16; kcg[i] = (bf16_t)pk2(p.in[4][((size_t)(b * 512 + l) * 2 + kv) * 64 + d], 0.f); }
        { const int l = i & 511, d = (i >> 9) & 63, kv = (i >> 15) & 1, b = i >> 16; vcgt[i] = (bf16_t)pk2(p.in[5][((size_t)(b * 512 + l) * 2 + kv) * 64 + d], 0.f); }
    }
}
DI void prep_phase(const Params& p, unsigned char* ws, LAS unsigned char* lds, int tid, int wid, int lane, int cb, int G) {
    mod_gemv(p, ws, lds, 0, G > 192 ? 1 : 2, cb * 8 + wid, G * 8, tid, lane);
    {
        const int gt = cb * 512 + tid, nth = G * 512;
        if (G <= 192) conv_caches(p, ws, gt, nth);
        unsigned* z0a = (unsigned*)(ws + WS_WQK + (size_t)1600 * D * 2); unsigned* z0b = (unsigned*)(ws + WS_WQK + (size_t)1728 * D * 2); unsigned* z1 = (unsigned*)(ws + WS_WV + (size_t)640 * D * 2);
        for (int i = gt; i < 65536; i += nth) { if (i < 32768) z0a[i] = 0u; else z0b[i - 32768] = 0u; z1[i] = 0u; }
        if (gt < 256) { const int ty = gt >> 6, d = gt & 63; ((float*)(ws + WS_GTAB))[gt] = ty == 0 ? p.in[17][d] : ty == 1 ? p.in[18][d] : ty == 2 ? p.in[20][d] : p.in[21][d]; }
    }
    convert_list(p, ws, lds, G > 192 ? 0x111 : 0xfff, cb * 8 + wid, G * 8, wid, lane);
}

DI void sw_rows(const Params& p, unsigned char* ws, int sel, int gw, int ngw, int lane) {
    float* swb = (float*)(ws + WS_SW); const float* mod = (const float*)(ws + WS_MOD);
#pragma unroll 1
    for (int ci = 0; ci < 7; ++ci) {
        if (!((sel >> ci) & 1)) continue;
        const bf16_t* W; int l, j, nrows, cstride; float* o;
        if (ci < 4) { W = (const bf16_t*)(ws + WS_W + (size_t)ci * FFN_STRIDE); l = ci >> 1; j = (ci & 1) ? 2 : 0; o = swb + ci * 3 * 5632; cstride = 5632; nrows = 5632; }
        else if (ci == 4) { W = (const bf16_t*)(ws + WS_WQK); l = 0; j = 1; o = swb + SW_QKV; cstride = 2560; nrows = 1792; }
        else if (ci == 5) { W = (const bf16_t*)(ws + WS_WV); l = 0; j = 1; o = swb + SW_QKV + 1792; cstride = 2560; nrows = 768; }
        else { W = (const bf16_t*)(ws + WS_WSI); l = 1; j = 1; o = swb + SW_SGU; cstride = 4096; nrows = 4096; }
        f32x4 sh[3][4];
#pragma unroll
        for (int c = 0; c < 3; ++c)
#pragma unroll
            for (int q = 0; q < 4; ++q) sh[c][q] = *(const f32x4*)(mod + (size_t)(l * 3 + c) * NMOD + 3 * j * D + lane * 16 + 4 * q);
        for (int row = gw; row < nrows; row += ngw) {
            const u32x4 w0 = *(const u32x4*)(W + (size_t)row * D + lane * 16), w1 = *(const u32x4*)(W + (size_t)row * D + lane * 16 + 8);
            float wf[16];
#pragma unroll
            for (int i = 0; i < 4; ++i) { wf[2 * i] = __builtin_bit_cast(float, w0[i] << 16); wf[2 * i + 1] = __builtin_bit_cast(float, w0[i] & 0xffff0000u);
                                          wf[8 + 2 * i] = __builtin_bit_cast(float, w1[i] << 16); wf[8 + 2 * i + 1] = __builtin_bit_cast(float, w1[i] & 0xffff0000u); }
            float a3[3];
#pragma unroll
            for (int c = 0; c < 3; ++c) { float a = 0.f;
#pragma unroll
                for (int q = 0; q < 4; ++q) a += (wf[4 * q] * sh[c][q][0] + wf[4 * q + 1] * sh[c][q][1]) + (wf[4 * q + 2] * sh[c][q][2] + wf[4 * q + 3] * sh[c][q][3]);
                a3[c] = wave_sum(a); }
            if (lane < 3) o[lane * cstride + row] = lane == 0 ? a3[0] : lane == 1 ? a3[1] : a3[2];
        }
    }
}

DI void phase1(const Params& p, unsigned char* ws, int gw, int ngw, int lane) {
    const float* mod = (const float*)(ws + WS_MOD);
    {
        const float* g = p.in[8];
        bf16_t* xn = (bf16_t*)(ws + WS_XN); float* rss0 = (float*)(ws + WS_CTL + WS_RSS);
        for (int m = gw; m < MTOK; m += ngw) {
            const int cond = m < MP ? 0 : 1 + ((m - MP) >> 11);
            const float* row = m < MP ? p.in[0] + (size_t)m * D : p.in[1] + (size_t)(m - MP) * D;
            const float* sc = mod + (cond * 9 + 1) * D;
            f32x4 v[4]; float ss = 0.f;
#pragma unroll
            for (int jj = 0; jj < 4; ++jj) { v[jj] = __builtin_nontemporal_load((const f32x4*)(row + 4 * lane + 256 * jj)); ss += (v[jj][0] * v[jj][0] + v[jj][1] * v[jj][1]) + (v[jj][2] * v[jj][2] + v[jj][3] * v[jj][3]); }
            ss = wave_sum(ss);
            if (lane == 0) rss0[m] = ss;
#pragma unroll
            for (int jj = 0; jj < 4; ++jj) { const int col = 4 * lane + 256 * jj;
                const f32x4 gg = *(const f32x4*)(g + col), s1 = *(const f32x4*)(sc + col);
                const f32x4 y = v[jj] * gg * (s1 + 1.f);
                u32x2 w; w.x = pk2(y[0], y[1]); w.y = pk2(y[2], y[3]); *(u32x2*)(xn + (size_t)m * D + col) = w; }
        }
    }
    sw_rows(p, ws, ngw > 1536 ? 0x31 : 0x7f, gw, ngw, lane);
}

#define MFMA32(a, b, c) __builtin_amdgcn_mfma_f32_32x32x16_bf16((a), (b), (c), 0, 0, 0)
constexpr int AT_ROW = 144;
constexpr int AT_KBUF = 0, AT_VBUF = 2 * 64 * AT_ROW, AT_RPB = 4 * 64 * AT_ROW, AT_TASK = AT_RPB + 2048;
struct ATask { const bf16_t* k0; const bf16_t* vt0; const bf16_t* kc; const bf16_t* vtc; int type, nsteps, urow0; };
DI void at_src(const ATask& T, int u, const bf16_t*& k, const bf16_t*& vt, int& vld) {
    if (T.type == 0) { k = T.k0 + (size_t)u * 4096; vt = T.vt0 + u * 64; vld = MTOK; }
    else if (T.type == 1) { if (u < 32) { k = T.k0 + (size_t)u * 4096; vt = T.vt0 + u * 64; vld = MTOK; } else { k = T.kc + (size_t)(u - 32) * 4096; vt = T.vtc + (u - 32) * 64; vld = 512; } }
    else { if (u < 8) { k = T.kc + (size_t)u * 4096; vt = T.vtc + u * 64; vld = 512; } else { const int tok = (T.urow0 + (u - 8)) * 64; k = T.k0 + (size_t)tok * 64; vt = T.vt0 + tok; vld = MTOK; } }
}
DI void at_gload(const ATask& T, int u, int tid, u32x4& a, u32x4& b) {
    const bf16_t* k; const bf16_t* vt; int vld; at_src(T, u, k, vt, vld);
    if (tid < 256) { const bf16_t* p = k + (tid >> 3) * 64 + (tid & 7) * 8; a = *(const u32x4*)p; b = *(const u32x4*)(p + 32 * 64); }
    else { const int j = tid - 256; const bf16_t* p = vt + (size_t)(j >> 2) * vld + (j & 3) * 8; a = *(const u32x4*)p; b = *(const u32x4*)(p + 32); }
}
DI void at_lstore(LAS unsigned char* lds, int buf, int tid, u32x4 a, u32x4 b) {
    if (tid < 256) { LAS unsigned char* p = lds + AT_KBUF + buf * 64 * AT_ROW + (tid >> 3) * AT_ROW + (tid & 7) * 16; *(LAS u32x4*)p = a; *(LAS u32x4*)(p + 32 * AT_ROW) = b; }
    else { const int j = tid - 256, c = j & 3, s = c >> 1, sec = c & 1; LAS unsigned char* row = lds + AT_VBUF + buf * 64 * AT_ROW + (j >> 2) * AT_ROW;
        const int o0 = ((s * 2 + 0) * 2 + sec) * 8, o1 = ((s * 2 + 1) * 2 + sec) * 8;
        *(LAS u32x2*)(row + o0) = (u32x2){a.x, a.y}; *(LAS u32x2*)(row + o1) = (u32x2){a.z, a.w};
        *(LAS u32x2*)(row + 64 + o0) = (u32x2){b.x, b.y}; *(LAS u32x2*)(row + 64 + o1) = (u32x2){b.z, b.w}; }
}
DI void attn_phase(const Params& p, unsigned char* ws, LAS unsigned char* lds, int tid, int wid, int lane, int rep) {
    unsigned char* R = ws + WS_R;
    const bf16_t* QNA = (const bf16_t*)(R + R_QNA); const bf16_t* KNA = (const bf16_t*)(R + R_KNA); const bf16_t* QG = (const bf16_t*)(R + R_QG); const bf16_t* KG = (const bf16_t*)(R + R_KG);
    const bf16_t* VT = (const bf16_t*)(R + R_VT); bf16_t* AO = (bf16_t*)(R + R_AO);
    const bf16_t* KCNA = (const bf16_t*)(ws + WS_KCNA); const bf16_t* VCNAT = (const bf16_t*)(ws + WS_VCNAT); const bf16_t* KCG = (const bf16_t*)(ws + WS_KCG); const bf16_t* VCGT = (const bf16_t*)(ws + WS_VCGT);
    unsigned* counter = (unsigned*)(ws + WS_CTL) + 64 * rep;
    LAS float* rpb_l = (LAS float*)(lds + AT_RPB); volatile LAS int* taskw = (volatile LAS int*)(lds + AT_TASK);
    const int r32 = lane & 31, hi = lane >> 5;
    for (;;) {
        if (tid == 0) taskw[0] = (int)atomicAdd(counter, 1u);
        __syncthreads();
        const int t = __builtin_amdgcn_readfirstlane(taskw[0]);
        if (t >= 768) break;
        ATask T; T.kc = nullptr; T.vtc = nullptr; T.urow0 = 0;
        const bf16_t* q; bf16_t* o; int r = 0, cblk = 0, row0 = 0;
        if (t < 128) {
            const int b = t >> 6, kv = (t >> 5) & 1, grp = t & 31, qh = kv * 4 + (grp >> 3), qb = (grp & 7) * 8 + wid, tok0 = MP + b * 2048;
            q = QG + ((size_t)qh * MTOK + tok0 + qb * 32) * 64; T.k0 = KG + ((size_t)kv * MTOK + tok0) * 64; T.vt0 = VT + (size_t)(512 + kv * 64) * MTOK + tok0;
            T.kc = KCG + (size_t)((b * 2 + kv) * 512) * 64; T.vtc = VCGT + (size_t)((b * 2 + kv) * 64) * 512; o = AO + (size_t)(tok0 + qb * 32) * D + 512 + qh * 64; T.type = 1; T.nsteps = 40;
        } else if (t < 256) {
            const int i = t - 128, b = i >> 6, h = (i >> 3) & 7, rg = i & 7, tok0 = MP + b * 2048;
            r = 4 * rg + (wid >> 1); cblk = wid & 1; row0 = min(max(r - 4, 0), 24);
            T.urow0 = min(max(4 * rg - 4, 0), 24); const int urow1 = min(max(4 * rg - 1, 0), 24) + 7;
            const int qb = r * 2 + cblk;
            q = QNA + ((size_t)h * MTOK + tok0 + qb * 32) * 64; T.k0 = KNA + ((size_t)h * MTOK + tok0) * 64; T.vt0 = VT + (size_t)(h * 64) * MTOK + tok0;
            T.kc = KCNA + (size_t)((b * 8 + h) * 512) * 64; T.vtc = VCNAT + (size_t)((b * 8 + h) * 64) * 512; o = AO + (size_t)(tok0 + qb * 32) * D + h * 64; T.type = 2; T.nsteps = 8 + (urow1 - T.urow0 + 1);
            if (tid < 465) rpb_l[tid] = p.in[19][h * 465 + tid] * LOG2E;
        } else {
            const int i = t - 256, isB = i >> 8, j = i & 255, b = j >> 3, h = j & 7, tok0 = b * 256, qb = wid;
            if (!isB) { q = QNA + ((size_t)h * MTOK + tok0 + qb * 32) * 64; T.k0 = KNA + ((size_t)h * MTOK + tok0) * 64; T.vt0 = VT + (size_t)(h * 64) * MTOK + tok0; o = AO + (size_t)(tok0 + qb * 32) * D + h * 64; }
            else { const int kv = h >> 2; q = QG + ((size_t)h * MTOK + tok0 + qb * 32) * 64; T.k0 = KG + ((size_t)kv * MTOK + tok0) * 64; T.vt0 = VT + (size_t)(512 + kv * 64) * MTOK + tok0; o = AO + (size_t)(tok0 + qb * 32) * D + 512 + h * 64; }
            T.type = 0; T.nsteps = 4;
        }
        const int ns = T.nsteps;
        u32x4 pa, pb, pc, pd; at_gload(T, 0, tid, pc, pd); at_gload(T, 1, tid, pa, pb);
        bf16x8 qf[4];
#pragma unroll
        for (int ks = 0; ks < 4; ++ks) qf[ks] = *(const bf16x8*)(q + r32 * 64 + ks * 16 + hi * 8);
        at_lstore(lds, 0, tid, pc, pd);
        float mrun = -1e30f, lrun = 0.f; f32x16 o0, o1;
#pragma unroll
        for (int i = 0; i < 16; ++i) { o0[i] = 0.f; o1[i] = 0.f; }
        __syncthreads();
        for (int u = 0; u < ns; ++u) {
            if (u + 1 < ns) at_lstore(lds, (u + 1) & 1, tid, pa, pb);
            if (u + 2 < ns) at_gload(T, u + 2, tid, pa, pb);
            bool active = true; const bool local = (T.type == 2 && u >= 8); int kr = 0;
            if (local) { kr = T.urow0 + (u - 8); active = (kr >= row0) && (kr < row0 + 8); }
            if (active) {
                const LAS unsigned char* kb = lds + AT_KBUF + (u & 1) * 64 * AT_ROW + r32 * AT_ROW + hi * 16;
                const LAS unsigned char* vb = lds + AT_VBUF + (u & 1) * 64 * AT_ROW + r32 * AT_ROW + hi * 16;
                f32x16 st[2];
#pragma unroll
                for (int h2 = 0; h2 < 2; ++h2) {
                    bf16x8 kf[4];
#pragma unroll
                    for (int ks = 0; ks < 4; ++ks) kf[ks] = *(const LAS bf16x8*)(kb + h2 * 32 * AT_ROW + ks * 32);
#pragma unroll
                    for (int i = 0; i < 16; ++i) st[h2][i] = 0.f;
#pragma unroll
                    for (int ks = 0; ks < 4; ++ks) st[h2] = MFMA32(kf[ks], qf[ks], st[h2]);
                }
                if (local) {
                    const int dr = kr - r + 7; const int qc = 32 * cblk + r32; const int wsq = min(max(qc - 8, 0), 48);
#pragma unroll
                    for (int h2 = 0; h2 < 2; ++h2) {
                        const int base = dr * 31 + 15 - qc + 32 * h2 + 4 * hi;
#pragma unroll
                        for (int i = 0; i < 16; ++i) { const int ko = (i & 3) + 8 * (i >> 2); const int kc = 32 * h2 + 4 * hi + ko; const bool ok = (kc >= wsq) && (kc < wsq + 16);
                            const float bias = rpb_l[ok ? base + ko : 0]; st[h2][i] = ok ? st[h2][i] + bias : -1e30f; }
                    }
                }
                float mx = fmaxf(fmaxf(st[0][0], st[0][1]), fmaxf(st[1][0], st[1][1]));
#pragma unroll
                for (int i = 2; i < 16; i += 2) mx = fmaxf(mx, fmaxf(fmaxf(st[0][i], st[0][i + 1]), fmaxf(st[1][i], st[1][i + 1])));
                mx = xor32_max(mx);
                if (__any(mx > mrun)) {
                    const float mnew = fmaxf(mrun, mx), alpha = __builtin_amdgcn_exp2f(mrun - mnew); mrun = mnew;
                    lrun *= alpha;
#pragma unroll
                    for (int i = 0; i < 16; ++i) { o0[i] *= alpha; o1[i] *= alpha; }
                }
                float ps0 = 0.f, ps1 = 0.f;
#pragma unroll
                for (int i = 0; i < 16; ++i) { st[0][i] = __builtin_amdgcn_exp2f(st[0][i] - mrun); ps0 += st[0][i]; st[1][i] = __builtin_amdgcn_exp2f(st[1][i] - mrun); ps1 += st[1][i]; }
                lrun += ps0 + ps1;
#pragma unroll
                for (int h2 = 0; h2 < 2; ++h2) {
                    u32x4 p0, p1;
                    p0.x = pk2(st[h2][0], st[h2][1]); p0.y = pk2(st[h2][2], st[h2][3]); p0.z = pk2(st[h2][4], st[h2][5]); p0.w = pk2(st[h2][6], st[h2][7]);
                    p1.x = pk2(st[h2][8], st[h2][9]); p1.y = pk2(st[h2][10], st[h2][11]); p1.z = pk2(st[h2][12], st[h2][13]); p1.w = pk2(st[h2][14], st[h2][15]);
                    const bf16x8 pf0 = __builtin_bit_cast(bf16x8, p0), pf1 = __builtin_bit_cast(bf16x8, p1);
                    bf16x8 vf[4];
#pragma unroll
                    for (int db = 0; db < 2; ++db)
#pragma unroll
                        for (int s = 0; s < 2; ++s) vf[db * 2 + s] = *(const LAS bf16x8*)(vb + db * 32 * AT_ROW + h2 * 64 + s * 32);
                    o0 = MFMA32(vf[0], pf0, o0); o0 = MFMA32(vf[1], pf1, o0);
                    o1 = MFMA32(vf[2], pf0, o1); o1 = MFMA32(vf[3], pf1, o1);
                }
            }
            __syncthreads();
        }
        lrun = xor32_sum(lrun);
        const float inv = 1.f / lrun;
        bf16_t* op = o + (size_t)r32 * D + 4 * hi;
#pragma unroll
        for (int gq = 0; gq < 4; ++gq) {
            u32x2 w0, w1;
            w0.x = pk2(o0[4 * gq] * inv, o0[4 * gq + 1] * inv); w0.y = pk2(o0[4 * gq + 2] * inv, o0[4 * gq + 3] * inv);
            w1.x = pk2(o1[4 * gq] * inv, o1[4 * gq + 1] * inv); w1.y = pk2(o1[4 * gq + 2] * inv, o1[4 * gq + 3] * inv);
            *(u32x2*)(op + 8 * gq) = w0; *(u32x2*)(op + 32 + 8 * gq) = w1;
        }
    }
}

DI void spatial_phase(const Params& p, unsigned char* ws, LAS unsigned char* lds, int tid, int wid, int lane, int cb, int G) {
    unsigned char* R = ws + WS_R;
    bf16_t* U = (bf16_t*)(R + R_U); const bf16_t* VTS = (const bf16_t*)(R + R_VTS);
    const float* rowss = (const float*)(ws + WS_CTL + 4096);
    const float* Ws = p.in[24]; const float* bs = p.in[25]; const float* vg = p.in[23];
    const int r32 = lane & 31, hi = lane >> 5, tb = wid & 3, dh = wid >> 2;
    for (int unit = cb; unit < 768; unit += G) {
        const int c = unit >> 3, g = unit & 7;
        const int t = 128 * c + 32 * tb + r32;
        u32x4 stg[8];
#pragma unroll
        for (int j = 0; j < 8; ++j) stg[j] = *(const u32x4*)(VTS + (size_t)(256 * g + (tid >> 4) + 32 * j) * MTOK + 128 * c + (tid & 15) * 8);
        f32x4 wst[8];
#pragma unroll
        for (int j = 0; j < 8; ++j) wst[j] = *(const f32x4*)(Ws + ((size_t)g * 128 + (tid >> 5) + 16 * j) * 128 + (tid & 31) * 4);
        const f32x4 rq = *(const f32x4*)(rowss + 128 * c + (tid & 31) * 4);
        u32x2 uu[4][4];
#pragma unroll
        for (int db = 0; db < 4; ++db)
#pragma unroll
            for (int gq = 0; gq < 4; ++gq) uu[db][gq] = *(const u32x2*)(U + (size_t)t * 2048 + 256 * g + 128 * dh + 32 * db + 8 * gq + 4 * hi);
        __syncthreads();
#pragma unroll
        for (int j = 0; j < 8; ++j) *(LAS u32x4*)(lds + ((tid >> 4) + 32 * j) * 272 + (tid & 15) * 16) = stg[j];
        { f32x4 r4;
#pragma unroll
          for (int i = 0; i < 4; ++i) r4[i] = rsqrtf(rq[i] * (1.f / 2048.f) + EPS);
#pragma unroll
          for (int j = 0; j < 8; ++j) { const f32x4 w = wst[j] * r4; u32x2 pw; pw.x = pk2(w[0], w[1]); pw.y = pk2(w[2], w[3]); *(LAS u32x2*)(lds + 69632 + ((tid >> 5) + 16 * j) * 272 + (tid & 31) * 8) = pw; } }
        __syncthreads();
        bf16x8 bfr[8];
#pragma unroll
        for (int ks = 0; ks < 8; ++ks) bfr[ks] = *(const LAS bf16x8*)(lds + 69632 + (32 * tb + r32) * 272 + (16 * ks + 8 * hi) * 2);
        const float bias = bs[g * 128 + 32 * tb + r32];
#pragma unroll
        for (int db = 0; db < 4; ++db) {
            f32x4 vg4[4];
#pragma unroll
            for (int gq = 0; gq < 4; ++gq) vg4[gq] = *(const f32x4*)(vg + 256 * g + 128 * dh + 32 * db + 8 * gq + 4 * hi);
            f32x16 acc;
#pragma unroll
            for (int i = 0; i < 16; ++i) acc[i] = 0.f;
#pragma unroll
            for (int ks = 0; ks < 8; ++ks) { const bf16x8 a = *(const LAS bf16x8*)(lds + (128 * dh + 32 * db + r32) * 272 + (16 * ks + 8 * hi) * 2); acc = MFMA32(a, bfr[ks], acc); }
#pragma unroll
            for (int gq = 0; gq < 4; ++gq) { const int d = 256 * g + 128 * dh + 32 * db + 8 * gq + 4 * hi;
                bf16_t* up = U + (size_t)t * 2048 + d; const u32x2 u2 = uu[db][gq];
                const float u0 = bf2f((unsigned short)(u2.x & 0xffffu)), u1 = bf2f((unsigned short)(u2.x >> 16)), u2f = bf2f((unsigned short)(u2.y & 0xffffu)), u3 = bf2f((unsigned short)(u2.y >> 16));
                u32x2 w; w.x = pk2(u0 * (acc[4 * gq] * vg4[gq][0] + bias), u1 * (acc[4 * gq + 1] * vg4[gq][1] + bias)); w.y = pk2(u2f * (acc[4 * gq + 2] * vg4[gq][2] + bias), u3 * (acc[4 * gq + 3] * vg4[gq][3] + bias));
                *(u32x2*)up = w; }
        }
    }
}

#define XB_TMO      128
#define XB_XCNT(j)  (256  + 64 * (j))
#define XB_XSUB(j)  (1280 + 64 * (j))
#define XB_XGEN(j)  (2304 + 64 * (j))
#define XB_TOP      3328
#define XB_TOPGEN   3392
#define XCD_BAR_WORDS 3456
#define XB_SPIN_CAP (1u << 18)
DI unsigned xb_ld(unsigned* p)              { return __hip_atomic_load(p, __ATOMIC_RELAXED, __HIP_MEMORY_SCOPE_AGENT); }
DI unsigned xb_add(unsigned* p, unsigned v) { return __hip_atomic_fetch_add(p, v, __ATOMIC_RELAXED, __HIP_MEMORY_SCOPE_AGENT); }
DI unsigned xb_xcc_id() { return (unsigned)__builtin_amdgcn_s_getreg((3 << 11) | 20) & 0xFu; }
#define XB_SPIN(cond, bar) do { unsigned _sp = 0; while (cond) { __builtin_amdgcn_s_sleep(1); \
    if ((++_sp & 255u) == 0u) { if (xb_ld(&(bar)[XB_TMO])) break; if (_sp > XB_SPIN_CAP) { atomicAdd(&(bar)[XB_TMO], 1u); break; } } } } while (0)
struct XcdBarrier { unsigned* bar; unsigned x; volatile LAS unsigned* st; };
DI XcdBarrier xcd_barrier_post(unsigned* bar, volatile LAS unsigned* st, int tid) {
    XcdBarrier b; b.bar = bar; b.x = xb_xcc_id(); b.st = st;
    if (tid == 0) (void)xb_add(&bar[XB_XCNT(b.x)], 1u);
    return b;
}
DI void xcd_barrier_complete(unsigned* bar, unsigned x, unsigned& nloc, unsigned& nx) {
    const unsigned G = gridDim.x * gridDim.y * gridDim.z;
    unsigned sum, cnt, mine, sp = 0u;
    for (;;) {
        sum = 0u; cnt = 0u; mine = 0u;
#pragma unroll
        for (unsigned j = 0; j < 16; ++j) { const unsigned c = xb_ld(&bar[XB_XCNT(j)]); sum += c; cnt += (c > 0u) ? 1u : 0u; mine = (j == x) ? c : mine; }
        if (sum == G) break;
        __builtin_amdgcn_s_sleep(1);
        if ((++sp & 255u) == 0u) { if (xb_ld(&bar[XB_TMO])) break; if (sp > XB_SPIN_CAP) { atomicAdd(&bar[XB_TMO], 1u); break; } }
    }
    nloc = mine > 0u ? mine : 1u; nx = cnt > 0u ? cnt : 1u;
}
DI void xcd_barrier(const XcdBarrier& b, int tid) {
    asm volatile("s_waitcnt vmcnt(0)" ::: "memory");
    __syncthreads();
    if (tid == 0) {
        unsigned* bar = b.bar;
        __builtin_amdgcn_s_waitcnt(0);
        unsigned nloc = b.st[0], nx = b.st[1];
        if (nloc == 0u) { xcd_barrier_complete(bar, b.x, nloc, nx); b.st[0] = nloc; b.st[1] = nx; }
        const unsigned old = xb_add(&bar[XB_XSUB(b.x)], 1u);
        const unsigned gen = old / nloc;
        if (old + 1u == (gen + 1u) * nloc) {
            __builtin_amdgcn_fence(__ATOMIC_RELEASE, "agent");
            asm volatile("s_waitcnt vmcnt(0)" ::: "memory");
            const unsigned og = xb_add(&bar[XB_TOP], 1u);
            const unsigned tg = og / nx;
            if (og + 1u == (tg + 1u) * nx) xb_add(&bar[XB_TOPGEN], 1u);
            else XB_SPIN(xb_ld(&bar[XB_TOPGEN]) == tg, bar);
            __builtin_amdgcn_fence(__ATOMIC_ACQUIRE, "agent");
            xb_add(&bar[XB_XGEN(b.x)], 1u);
            asm volatile("s_waitcnt vmcnt(0)" ::: "memory");
        } else {
            XB_SPIN(xb_ld(&bar[XB_XGEN(b.x)]) == gen, bar);
            __builtin_amdgcn_fence(__ATOMIC_ACQUIRE, "agent");
            asm volatile("s_waitcnt vmcnt(0)" ::: "memory");
        }
    }
    __syncthreads();
}

__global__ void __launch_bounds__(512, 2) mega_fwd(Params p) {
    extern __shared__ __attribute__((aligned(16))) unsigned char lds_raw[];
    LAS unsigned char* lds = (LAS unsigned char*)lds_raw;
    volatile LAS unsigned* misc = (volatile LAS unsigned*)(lds + LDS_BYTES - 64);
    const int wave_s = __builtin_amdgcn_readfirstlane((int)threadIdx.x >> 6);
    { const int t0 = wave_s * 64 + (int)__lane_id(); if (t0 < 4) misc[t0] = 0u; }
    __syncthreads();
    XcdBarrier bar = xcd_barrier_post((unsigned*)(p.ws + WS_CTL + 65536), misc, wave_s * 64 + (int)__lane_id());
    for (int ph = p.ph_lo; ph < p.ph_hi; ++ph) {
      const int nrep = (ph == p.rep_ph) ? p.rep_n : 1;
      for (int rep = 0; rep < nrep; ++rep) {
        int wv_ = wave_s; asm volatile("" : "+s"(wv_)); int lid_; asm volatile("v_mbcnt_lo_u32_b32 %0, -1, 0\n\tv_mbcnt_hi_u32_b32 %0, -1, %0" : "=&v"(lid_)); int tid = wv_ * 64 + lid_;
        int cb = blockIdx.x; asm volatile("" : "+s"(cb));
        int G = gridDim.x; asm volatile("" : "+s"(G));
        size_t wz = 0; asm volatile("" : "+s"(wz)); unsigned char* ws = p.ws + wz;
        const int lane = tid & 63, wid = __builtin_amdgcn_readfirstlane(tid >> 6);
        const int gw = cb * 8 + wid, ngw = G * 8;
        const bf16_t* XN = (const bf16_t*)(ws + WS_XN);
        const float* mod = (const float*)(ws + WS_MOD);
        float* rssb = (float*)(ws + WS_CTL + WS_RSS); const float* swb = (const float*)(ws + WS_SW);
        const bool tailmode = G >= 224;
        unsigned* tailcnt = (unsigned*)(ws + WS_CTL + 57344);
        if (ph == 0) prep_phase(p, ws, lds, tid, wid, lane, cb, G);
        else if (ph == 1) phase1(p, ws, gw, ngw, lane);
        else {
            const int l = (ph - 2) / 7, r = (ph - 2) % 7;
            if (r == 0 || r == 5) {
                const int f = (r == 5) ? 1 : 0, mi = l * 2 + f, ni = l * 3 + (f ? 2 : 0);
                const char* Wg = (const char*)(ws + WS_W + (size_t)mi * FFN_STRIDE);
                pg8::GemmDesc g0{(const char*)XN, Wg, tailmode ? 32 : 48, 22, 0, 0}, g1{(const char*)XN + (size_t)32 * 256 * D * 2, Wg, tailmode ? 16 : 0, tailmode ? 20 : 0, 32, 0};
                pg8::Sched2 S; S.init(g0, g1, D, G, cb);
                EpiGU E{(bf16_t*)(ws + WS_R + R_HID), rssb + ni * MTOK, swb + mi * 3 * 5632};
                pg8::gemm_phase<EpiGU, pg8::Sched2>(lds, tid, D, S, E);
            } else if (r == 1 || r == 6 || r == 4) {
                const char* A; const char* B; int K, jdx, nl, nj; float w;
                if (r == 4) { jdx = 1; w = 1.f; nl = l; nj = 2; if (l == 0) { A = (const char*)(ws + WS_R + R_AO); B = (const char*)(ws + WS_WO); K = 1024; } else { A = (const char*)(ws + WS_R + R_U); B = (const char*)(ws + WS_WSO); K = 2048; } }
                else { const int f = (r == 6) ? 1 : 0, mi = l * 2 + f; jdx = f ? 2 : 0; w = 0.5f; A = (const char*)(ws + WS_R + R_HID); B = (const char*)(ws + WS_W + (size_t)mi * FFN_STRIDE + FFN_DOWN); K = FH;
                       if (f == 0) { nl = l; nj = 1; } else { nl = l + 1; nj = 0; } }
                pg8::GemmDesc g0{A, B, 48, 4, 0, 0}, g1{nullptr, nullptr, 0, 0, 0, 0};
                pg8::Sched2 S; S.init(g0, g1, K, G, cb);
                const int ffn = (r == 4) ? -1 : l * 2 + ((r == 6) ? 1 : 0);
                EpiRes E{p.out, mod, p.in[8], ws, p.in[0], p.in[1], l, 3 * jdx + 2, nl < 2 ? nl * 3 + nj : -1, (tailmode && ffn >= 0) ? tailcnt + ffn * 256 : nullptr};
                pg8::gemm_phase<EpiRes, pg8::Sched2>(lds, tid, K, S, E);
                if (cb >= 192 && G > 192) {
                    int lid2; asm volatile("v_mbcnt_lo_u32_b32 %0, -1, 0\n\tv_mbcnt_hi_u32_b32 %0, -1, %0" : "=&v"(lid2)); int tid2 = wv_ * 64 + lid2;
                    if (tailmode && ffn >= 0 && cb < 224) {
                        const char* Wg = (const char*)(ws + WS_W + (size_t)ffn * FFN_STRIDE);
                        pg8::GemmDesc t0{(const char*)XN + (size_t)32 * 256 * D * 2, Wg + (size_t)20 * 256 * D * 2, 16, 2, 32, 20}, t1{nullptr, nullptr, 0, 0, 0, 0};
                        pg8::Sched2 ST; ST.init(t0, t1, D, 32, cb - 192);
                        EpiGU EG{(bf16_t*)(ws + WS_R + R_HID), rssb + (l * 3 + ((r == 6) ? 2 : 0)) * MTOK, swb + ffn * 3 * 5632};
                        pg8::gemm_phase<EpiGU, pg8::Sched2>(lds, tid2, D, ST, EG);
                        pg8::Unit tu; ST.next(0, tu);
                        asm volatile("s_waitcnt vmcnt(0)" ::: "memory"); __syncthreads();
                        asm volatile("v_mbcnt_lo_u32_b32 %0, -1, 0\n\tv_mbcnt_hi_u32_b32 %0, -1, %0" : "=&v"(lid2)); tid2 = wv_ * 64 + lid2;
                        if (tid2 == 0) { __builtin_amdgcn_fence(__ATOMIC_RELEASE, "agent"); asm volatile("s_waitcnt vmcnt(0)" ::: "memory");
                                        __hip_atomic_fetch_add(tailcnt + ffn * 256 + (tu.pm - 32) * 16, 1u, __ATOMIC_RELAXED, __HIP_MEMORY_SCOPE_AGENT); }
                        __syncthreads();
                    }
                    const int igw = (cb - 192) * 8 + wid, ingw = (G - 192) * 8;
                    if (ph == 3) { conv_caches(p, ws, (cb - 192) * 512 + tid2, (G - 192) * 512); convert_list(p, ws, lds, (1 << 1) | (1 << 5) | (1 << 9), igw, ingw, wid, lid2); }
                    else if (ph == 6) { mod_gemv(p, ws, lds, 1, 2, igw, ingw, tid2, lid2); convert_list(p, ws, lds, (1 << 2), igw, ingw, wid, lid2); sw_rows(p, ws, (1 << 1), igw, ingw, lid2); }
                    else if (ph == 8) { convert_list(p, ws, lds, (1 << 6) | (1 << 10), igw, ingw, wid, lid2); sw_rows(p, ws, (1 << 2), igw, ingw, lid2); }
                    else if (ph == 10) { convert_list(p, ws, lds, (1 << 3) | (1 << 7) | (1 << 11), igw, ingw, wid, lid2); sw_rows(p, ws, (1 << 6), igw, ingw, lid2); }
                    else if (ph == 13) sw_rows(p, ws, (1 << 3), igw, ingw, lid2);
                }
            } else if (r == 2) {
                if (l == 0) {
                    pg8::GemmDesc g0{(const char*)XN, (const char*)(ws + WS_WQK), 48, 7, 0, 0}, g1{(const char*)(ws + WS_WV), (const char*)XN, 3, 48, 0, 0};
                    pg8::Sched2 S; S.init(g0, g1, D, G, cb);
                    unsigned char* R = ws + WS_R;
                    EpiQKV E{(bf16_t*)(R + R_QNA), (bf16_t*)(R + R_VT), p.out, (const float*)(ws + WS_GTAB), rssb + 1 * MTOK, swb + SW_QKV};
                    pg8::gemm_phase<EpiQKV, pg8::Sched2>(lds, tid, D, S, E);
                } else {
                    pg8::GemmDesc g0{(const char*)XN, (const char*)(ws + WS_WSI), 48, 8, 0, 0}, g1{(const char*)(ws + WS_WSI + (size_t)2048 * D * 2), (const char*)XN, 8, 48, 0, 0};
                    pg8::Sched2 S; S.init(g0, g1, D, G, cb);
                    EpiSGU E{(bf16_t*)(ws + WS_R + R_U), (bf16_t*)(ws + WS_R + R_VTS), (float*)(ws + WS_CTL + 4096), rssb + 4 * MTOK, swb + SW_SGU};
                    pg8::gemm_phase<EpiSGU, pg8::Sched2>(lds, tid, D, S, E);
                }
            } else {
                if (l == 0) attn_phase(p, ws, lds, tid, wid, lane, rep); else spatial_phase(p, ws, lds, tid, wid, lane, cb, G);
            }
        }
        if (ph + 1 < p.ph_hi || rep + 1 < nrep) {
            { XcdBarrier b2 = bar; size_t bz = 0; asm volatile("" : "+s"(bz)); b2.bar = bar.bar + bz; xcd_barrier(b2, tid); }
        }
      }
    }
}

extern "C" void kernel_launch(void* const* d_in, const int* in_sizes, int n_in, void* d_out, int out_size, void* d_ws, size_t ws_size, hipStream_t stream) {
    static int grid = 0;
    if (grid == 0) {
        if (n_in != 27 || ws_size < WS_END) { fprintf(stderr, "kernel_launch: unexpected n_in %d / ws_size %zu\n", n_in, ws_size); grid = -1; return; }
        int dev = 0, cus = 0, per_cu = 0;
        (void)hipGetDevice(&dev);
        (void)hipDeviceGetAttribute(&cus, hipDeviceAttributeMultiprocessorCount, dev);
        if (hipFuncSetAttribute((const void*)mega_fwd, hipFuncAttributeMaxDynamicSharedMemorySize, LDS_BYTES) != hipSuccess) { fprintf(stderr, "kernel_launch: hipFuncSetAttribute failed\n"); grid = -1; return; }
        if (hipOccupancyMaxActiveBlocksPerMultiprocessor(&per_cu, (const void*)mega_fwd, 512, LDS_BYTES) != hipSuccess || per_cu < 1) { fprintf(stderr, "kernel_launch: occupancy query says %d\n", per_cu); grid = -1; (void)hipGetLastError(); return; }
        grid = cus;
    }
    if (grid < 0) return;
    (void)hipMemsetAsync((char*)d_ws + WS_CTL, 0, CTL_BYTES, stream);
    Params p{};
    for (int i = 0; i < 27; ++i) p.in[i] = (const float*)d_in[i];
    p.out = (float*)d_out; p.ws = (unsigned char*)d_ws; p.ph_lo = 0; p.ph_hi = 16; p.rep_ph = -1; p.rep_n = 1;
    void* args[] = {&p};
    hipError_t e = hipLaunchCooperativeKernel((const void*)mega_fwd, dim3(grid), dim3(512), args, LDS_BYTES, stream);
    if (e != hipSuccess) fprintf(stderr, "cooperative launch failed: %s (grid %d)\n", hipGetErrorString(e), grid);
}
```

```cpp
#include <hip/hip_runtime.h>
#include <hip/hip_cooperative_groups.h>
#include <cstdio>
#include <cstdint>
namespace cg = cooperative_groups;

#define LAS __attribute__((address_space(3)))
#define DI __device__ __forceinline__
typedef unsigned short bf16_t;
typedef short bf16x8 __attribute__((ext_vector_type(8)));
typedef float f32x4 __attribute__((ext_vector_type(4)));
typedef float f32x2 __attribute__((ext_vector_type(2)));
typedef float f32x16 __attribute__((ext_vector_type(16)));
typedef unsigned u32x4 __attribute__((ext_vector_type(4)));
typedef unsigned u32x2 __attribute__((ext_vector_type(2)));
typedef __bf16 bf16x2_t __attribute__((ext_vector_type(2)));

constexpr int D = 1024, MTOK = 12288, MP = 8192, FH = 2816, NMOD = 9216;
constexpr float LOG2E = 1.4426950408889634f;
constexpr float EPS = 1e-6f;
constexpr size_t O_NAK = 12582912, O_NAV = 16777216, O_GK = 20971520, O_GV = 22020096;
constexpr size_t MiB = 1u << 20;
constexpr size_t WS_CTL = 0, CTL_BYTES = 704 * 1024;
constexpr size_t WS_RSS = 131072;
constexpr size_t WS_SW = 5 * MiB;
constexpr int SW_QKV = 4 * 3 * 5632, SW_SGU = SW_QKV + 3 * 2560;
constexpr size_t WS_GTAB = 768 * 1024;
constexpr size_t WS_MOD = 448 * 1024;
constexpr size_t WS_KCNA = 2 * MiB, WS_VCNAT = 3 * MiB, WS_KCG = 4 * MiB, WS_VCGT = 4 * MiB + 256 * 1024;
constexpr size_t WS_W = 8 * MiB, FFN_STRIDE = 17301504, FFN_DOWN = 11 * MiB;
constexpr size_t WS_WQK = 74 * MiB, WS_WV = WS_WQK + 3670016, WS_WO = 79 * MiB, WS_WSI = 81 * MiB, WS_WSO = 89 * MiB;
constexpr size_t WS_XN = 96 * MiB;
constexpr size_t WS_R = 120 * MiB;
constexpr size_t R_HID = 0;
constexpr size_t R_QNA = 0, R_KNA = 12 * MiB, R_QG = 24 * MiB, R_KG = 36 * MiB, R_VT = 40 * MiB, R_AO = 58 * MiB;
constexpr size_t R_U = 0, R_VTS = 48 * MiB;
constexpr size_t WS_END = 216 * MiB;
constexpr int LDS_BYTES = 135168;

struct Params { const float* in[27]; float* out; unsigned char* ws; int ph_lo, ph_hi, rep_ph, rep_n; };

DI unsigned pk2(float lo, float hi) { f32x2 v = {lo, hi}; bf16x2_t b = __builtin_convertvector(v, bf16x2_t); return __builtin_bit_cast(unsigned, b); }
DI float bf2f(unsigned short b) { return __builtin_bit_cast(float, (unsigned)b << 16); }
template <int CTRL> DI float dppf(float v) { return __builtin_bit_cast(float, __builtin_amdgcn_update_dpp(0, __builtin_bit_cast(int, v), CTRL, 0xf, 0xf, true)); }
DI float row16_sum(float v) { v += dppf<0xB1>(v); v += dppf<0x4E>(v); v += dppf<0x124>(v); v += dppf<0x128>(v); return v; }
DI float xor16_sum(float v) { const unsigned b = __builtin_bit_cast(unsigned, v); auto r = __builtin_amdgcn_permlane16_swap(b, b, false, false); return __builtin_bit_cast(float, (unsigned)r[0]) + __builtin_bit_cast(float, (unsigned)r[1]); }
DI float xor32_sum(float v) { const unsigned b = __builtin_bit_cast(unsigned, v); auto r = __builtin_amdgcn_permlane32_swap(b, b, false, false); return __builtin_bit_cast(float, (unsigned)r[0]) + __builtin_bit_cast(float, (unsigned)r[1]); }
DI float xor32_max(float v) { const unsigned b = __builtin_bit_cast(unsigned, v); auto r = __builtin_amdgcn_permlane32_swap(b, b, false, false); return fmaxf(__builtin_bit_cast(float, (unsigned)r[0]), __builtin_bit_cast(float, (unsigned)r[1])); }
DI float wave_sum(float v) { return xor32_sum(xor16_sum(row16_sum(v))); }
DI float silu_f(float x) { return x * __builtin_amdgcn_rcpf(1.f + __builtin_amdgcn_exp2f(-x * LOG2E)); }
DI f32x2 gelu_pk(f32x2 v) {
    const f32x2 av = __builtin_elementwise_abs(v), d = av * 0.2316418882f + 1.0f;
    f32x2 t; t.x = __builtin_amdgcn_rcpf(d.x); t.y = __builtin_amdgcn_rcpf(d.y);
    f32x2 q = t * 0.5307027145f + (-0.7265760135f); q = q * t + 0.7107068705f; q = q * t + (-0.142248368f); q = q * t + 0.127414796f; q = q * t;
    const f32x2 s = (v * v) * (-0.72134752044f);
    f32x2 e; e.x = __builtin_amdgcn_exp2f(s.x); e.y = __builtin_amdgcn_exp2f(s.y);
    const f32x2 m = v * (q * e), r = v - m;
    f32x2 o; o.x = v.x < 0.f ? m.x : r.x; o.y = v.y < 0.f ? m.y : r.y; return o;
}
DI f32x4 gelu4(f32x4 v) { f32x2 a = gelu_pk((f32x2){v[0], v[1]}), b = gelu_pk((f32x2){v[2], v[3]}); return (f32x4){a.x, a.y, b.x, b.y}; }

namespace pg8 {
constexpr int BM = 256, BK = 64, HALF = 128, HTB = HALF * BK * 2, NXCD = 8, WGM = 8;
DI int lds_byte(int r, int c) { const int st = (r >> 4) * 2 + (c >> 5), rr = r & 15, cc = c & 31, ob = rr * 64 + cc * 2; return st * 1024 + (ob ^ (((ob >> 9) & 1) << 5)); }
DI void stage_rc(int b, int& R, int& C) { const int st = b / 1024, sb = b % 1024, swz = sb ^ (((sb >> 9) & 1) << 5); R = (st >> 1) * 16 + swz / 64; C = (st & 1) * 32 + (swz % 64) / 2; }
DI int perm32(int rho) { const int n = rho >> 4, i = rho & 15; return 8 * (i >> 2) + 4 * n + (i & 3); }

struct Unit { const char* a; const char* b; int pm, pn, kind; };
struct GemmDesc { const char* A; const char* B; int nM, nN, pmoff, pnoff; };
struct Sched2 {
    GemmDesc g0, g1; int nwg0, nwg, G, c; size_t tstep;
    DI void init(const GemmDesc& a, const GemmDesc& b, int K, int G_, int c_) { g0 = a; g1 = b; nwg0 = a.nM * a.nN; nwg = nwg0 + b.nM * b.nN; G = G_; c = c_; tstep = (size_t)BM * K * 2; }
    DI bool next(int i, Unit& u) const {
        const long L = (long)i * G + c; if (L >= nwg) return false;
        int wgid = (int)L;
        if ((G & 7) == 0) { const int q = nwg / NXCD, r = nwg % NXCD, xcd = wgid % NXCD, off = wgid / NXCD; wgid = (xcd < r ? xcd * (q + 1) : r * (q + 1) + (xcd - r) * q) + off; }
        const bool k1 = wgid >= nwg0; if (k1) wgid -= nwg0;
        const int nM = k1 ? g1.nM : g0.nM, nN = k1 ? g1.nN : g0.nN;
        const int nig = WGM * nN, gid = wgid / nig, fm = gid * WGM, gsz = (nM - fm) < WGM ? (nM - fm) : WGM;
        const int lpm = fm + ((wgid % nig) % gsz), lpn = (wgid % nig) / gsz; u.kind = k1 ? 1 : 0;
        u.a = (k1 ? g1.A : g0.A) + (size_t)lpm * tstep; u.b = (k1 ? g1.B : g0.B) + (size_t)lpn * tstep;
        u.pm = lpm + (k1 ? g1.pmoff : g0.pmoff); u.pn = lpn + (k1 ? g1.pnoff : g0.pnoff);
        return true;
    }
};

template <class Epi, class Sched>
DI void gemm_phase(LAS unsigned char* lds, const int tid, const int K, const Sched& S, const Epi& E) {
    const int wid = __builtin_amdgcn_readfirstlane(tid >> 6), lane = tid & 63, wr = wid >> 2, wc = wid & 3, fr = lane & 15, fq = lane >> 4;
    const int nt = K / BK;
    unsigned voffA[2], voffB[2];
#pragma unroll
    for (int i = 0; i < 2; ++i) { int R, C; stage_rc(tid * 16 + i * 8192, R, C); const int Rb = Epi::PERM ? ((R & ~31) + perm32(R & 31)) : R;
        voffA[i] = (unsigned)(R * K + C) * 2u; voffB[i] = (unsigned)(Rb * K + C) * 2u; }
    const size_t kstep = (size_t)(BK * 2);
    const size_t hstep = (size_t)HALF * K * 2;
    const unsigned ldsw = (unsigned)wid * 1024u;
    const int aoff = lds_byte(wr * 64 + fr, fq * 8), boff = lds_byte(wc * 32 + fr, fq * 8);
#define PG8_SA(b, h) (((b) * 2 + (h)) * HTB)
#define PG8_SB(b, h) ((4 + (b) * 2 + (h)) * HTB)
#define PG8_STAGE(bufoff, gbase, voff) do { _Pragma("unroll") for (int _i = 0; _i < 2; ++_i) \
        __builtin_amdgcn_global_load_lds((const unsigned*)((const char*)(gbase) + (voff)[_i]), (LAS unsigned*)(lds + (bufoff) + ldsw + _i * 8192), 16, 0, 0); } while (0)
#define PG8_LDA(dst, b, h) do { _Pragma("unroll") for (int m = 0; m < 4; ++m) _Pragma("unroll") for (int k = 0; k < 2; ++k) dst[m][k] = *(const LAS bf16x8*)(lds + PG8_SA(b, h) + aoff + m * 2048 + k * 1024); } while (0)
#define PG8_LDB(dst, b, h) do { _Pragma("unroll") for (int n = 0; n < 2; ++n) _Pragma("unroll") for (int k = 0; k < 2; ++k) dst[n][k] = *(const LAS bf16x8*)(lds + PG8_SB(b, h) + boff + n * 2048 + k * 1024); } while (0)
#define PG8_MMA(ai, bj, At, Bt) do { __builtin_amdgcn_s_setprio(1); _Pragma("unroll") for (int m = 0; m < 4; ++m) _Pragma("unroll") for (int n = 0; n < 2; ++n) _Pragma("unroll") for (int k = 0; k < 2; ++k) \
        acc[ai][bj][m][n] = __builtin_amdgcn_mfma_f32_16x16x32_bf16(Bt[n][k], At[m][k], acc[ai][bj][m][n], 0, 0, 0); __builtin_amdgcn_s_setprio(0); } while (0)
#define PG8_WAIT_V(n) asm volatile("s_waitcnt vmcnt(" #n ")" ::: "memory")
#define PG8_WAIT_L(n) asm volatile("s_waitcnt lgkmcnt(" #n ")" ::: "memory")
#define PG8_BAR __builtin_amdgcn_s_barrier()
#define PG8_SCHED __builtin_amdgcn_sched_barrier(0)
    Unit cur, nxt; int ui = 0;
    if (!S.next(0, cur)) return;
    f32x4 acc[2][2][4][2];
#pragma unroll
    for (int a = 0; a < 2; ++a)
#pragma unroll
        for (int b = 0; b < 2; ++b)
#pragma unroll
            for (int m = 0; m < 4; ++m)
#pragma unroll
                for (int n = 0; n < 2; ++n) acc[a][b][m][n] = (f32x4){0.f, 0.f, 0.f, 0.f};
    bf16x8 At[4][2], B0[2][2], B1[2][2];
    const char* cA = cur.a; const char* cB = cur.b;
    PG8_STAGE(PG8_SB(0, 0), cB, voffB); PG8_STAGE(PG8_SB(0, 1), cB + hstep, voffB); PG8_STAGE(PG8_SA(0, 0), cA, voffA); PG8_STAGE(PG8_SA(0, 1), cA + hstep, voffA);
    if (wr == 1) PG8_BAR;
    PG8_WAIT_V(2); PG8_BAR;
    PG8_STAGE(PG8_SB(1, 0), cB + kstep, voffB); PG8_STAGE(PG8_SA(1, 0), cA + kstep, voffA); PG8_STAGE(PG8_SB(1, 1), cB + hstep + kstep, voffB);
    PG8_WAIT_V(6); PG8_BAR;
    for (;;) {
        const bool has_next = S.next(ui + 1, nxt);
        const char* nA = has_next ? nxt.a : cA; const char* nB = has_next ? nxt.b : cB;
        for (int t = 0; t < nt; t += 2) {
            if constexpr (Epi::KWAIT) { if (t == nt - 6 && E.need_wait(cur)) E.do_wait(cur, wid); }
            const bool last = (t == nt - 2);
            const char* a1 = cA + (size_t)(t + 1) * kstep;
            const char* a2 = last ? nA : cA + (size_t)(t + 2) * kstep; const char* b2 = last ? nB : cB + (size_t)(t + 2) * kstep;
            const char* a3 = a2 + kstep; const char* b3 = b2 + kstep;
            PG8_LDB(B0, 0, 0); PG8_LDB(B1, 0, 1); PG8_SCHED; PG8_LDA(At, 0, 0); PG8_STAGE(PG8_SA(1, 1), a1 + hstep, voffA);
            PG8_WAIT_V(8); PG8_WAIT_L(0); PG8_BAR; PG8_MMA(0, 0, At, B0); PG8_MMA(0, 1, At, B1); PG8_BAR; PG8_SCHED;
            PG8_LDA(At, 0, 1); PG8_STAGE(PG8_SB(0, 0), b2, voffB); PG8_STAGE(PG8_SB(0, 1), b2 + hstep, voffB); PG8_STAGE(PG8_SA(0, 0), a2, voffA);
            PG8_WAIT_V(8); PG8_WAIT_L(0); PG8_BAR; PG8_MMA(1, 0, At, B0); PG8_MMA(1, 1, At, B1); PG8_BAR; PG8_SCHED;
            PG8_LDB(B0, 1, 0); PG8_LDB(B1, 1, 1); PG8_SCHED; PG8_LDA(At, 1, 0); PG8_STAGE(PG8_SA(0, 1), a2 + hstep, voffA);
            PG8_WAIT_V(8); PG8_WAIT_L(0); PG8_BAR; PG8_MMA(0, 0, At, B0); PG8_MMA(0, 1, At, B1); PG8_BAR; PG8_SCHED;
            PG8_LDA(At, 1, 1); PG8_STAGE(PG8_SB(1, 0), b3, voffB); PG8_STAGE(PG8_SB(1, 1), b3 + hstep, voffB); PG8_STAGE(PG8_SA(1, 0), a3, voffA);
            PG8_WAIT_V(8); PG8_WAIT_L(0); PG8_BAR; PG8_MMA(1, 0, At, B0); PG8_MMA(1, 1, At, B1); PG8_BAR; PG8_SCHED;
        }
        if (wr == 0) PG8_BAR;
        E(acc, cur, wr, wc, fr, fq);
        if (!has_next) break;
#pragma unroll
        for (int a = 0; a < 2; ++a)
#pragma unroll
            for (int b = 0; b < 2; ++b)
#pragma unroll
                for (int m = 0; m < 4; ++m)
#pragma unroll
                    for (int n = 0; n < 2; ++n) acc[a][b][m][n] = (f32x4){0.f, 0.f, 0.f, 0.f};
        cur = nxt; cA = nA; cB = nB; ++ui;
        if (wr == 1) PG8_BAR;
    }
    PG8_WAIT_V(0);
    PG8_BAR;
#undef PG8_SA
#undef PG8_SB
#undef PG8_STAGE
#undef PG8_LDA
#undef PG8_LDB
#undef PG8_MMA
#undef PG8_WAIT_V
#undef PG8_WAIT_L
#undef PG8_BAR
#undef PG8_SCHED
}
}

struct EpiGU {
    static constexpr bool PERM = true, KWAIT = false; bf16_t* H; const float* rss; const float* sw;
    DI void operator()(const f32x4 (&acc)[2][2][4][2], const pg8::Unit& u, int wr, int wc, int fr, int fq) const {
        asm volatile("" : "+v"(fr), "+v"(fq));
        const int row0 = u.pm * 256 + wr * 64 + fr, col0 = u.pn * 128 + wc * 32 + 8 * fq;
        const int cond = u.pm < 32 ? 0 : 1 + ((u.pm - 32) >> 3);
        const float* swp = sw + cond * 5632 + u.pn * 256 + wc * 32 + 8 * fq;
        const f32x4 sg0 = *(const f32x4*)(swp), sg1 = *(const f32x4*)(swp + 4), su0 = *(const f32x4*)(swp + 128), su1 = *(const f32x4*)(swp + 132);
        float rs8[8];
#pragma unroll
        for (int it = 0; it < 8; ++it) rs8[it] = rss[row0 + (it >> 2) * 128 + (it & 3) * 16];
#pragma unroll
        for (int ai = 0; ai < 2; ++ai)
#pragma unroll
            for (int m = 0; m < 4; ++m) {
                const int row = row0 + ai * 128 + m * 16;
                const float rstd = rsqrtf(rs8[ai * 4 + m] * (1.f / D) + EPS);
                bf16_t* rowp = H + (size_t)row * FH + col0;
                const f32x4 g0 = acc[ai][0][m][0] * rstd + sg0, g1 = acc[ai][0][m][1] * rstd + sg1, u0 = acc[ai][1][m][0] * rstd + su0, u1 = acc[ai][1][m][1] * rstd + su1;
                u32x4 w;
                w.x = pk2(silu_f(g0[0]) * u0[0], silu_f(g0[1]) * u0[1]); w.y = pk2(silu_f(g0[2]) * u0[2], silu_f(g0[3]) * u0[3]);
                w.z = pk2(silu_f(g1[0]) * u1[0], silu_f(g1[1]) * u1[1]); w.w = pk2(silu_f(g1[2]) * u1[2], silu_f(g1[3]) * u1[3]);
                *(u32x4*)rowp = w;
                __builtin_amdgcn_sched_barrier(0);
            }
    }
};
struct EpiRes {
    static constexpr bool PERM = false, KWAIT = true; float* out; const float* mod; const float* normg; unsigned char* ws; const float* xp; const float* xs; int l, gidx, ni; unsigned* tcnt;
    DI bool need_wait(const pg8::Unit& u) const { return tcnt != nullptr && u.pm >= 32; }
    DI void do_wait(const pg8::Unit& u, int wid) const {
        if (wid == 0) { unsigned sp = 0; while ((unsigned)__builtin_amdgcn_readfirstlane(__hip_atomic_load(tcnt + (u.pm - 32) * 16, __ATOMIC_RELAXED, __HIP_MEMORY_SCOPE_AGENT)) < 2u) { __builtin_amdgcn_s_sleep(2); if (++sp > (1u << 22)) break; }
            __builtin_amdgcn_fence(__ATOMIC_ACQUIRE, "agent"); asm volatile("s_waitcnt vmcnt(0)" ::: "memory"); }
        asm volatile("" ::: "memory"); __builtin_amdgcn_s_barrier(); asm volatile("" ::: "memory");
    }
    DI void operator()(const f32x4 (&acc)[2][2][4][2], const pg8::Unit& u, int wr, int wc, int fr, int fq) const {
        asm volatile("" : "+v"(fr), "+v"(fq));
        const int cond = u.pm < 32 ? 0 : 1 + ((u.pm - 32) >> 3);
        const float* gate = mod + (size_t)l * 3 * NMOD + (cond * 9 + gidx) * D;
        const float w = gidx == 5 ? 1.f : 0.5f;
        const bool nn = ni >= 0; const int nl = nn ? ni / 3 : 0, nj = nn ? ni - 3 * nl : 0;
        const float* ng = normg + (nn ? ni : 0) * D; const float* nscale = mod + (size_t)nl * 3 * NMOD + (cond * 9 + 3 * nj + 1) * D;
        float* rss = (float*)(ws + WS_CTL + WS_RSS) + (nn ? ni : 0) * MTOK; bf16_t* xn = (bf16_t*)(ws + WS_XN);
        const int col0 = u.pn * 256 + wc * 32 + 4 * fq;
        f32x4 gv[2][2], gs[2][2];
#pragma unroll
        for (int bj = 0; bj < 2; ++bj)
#pragma unroll
            for (int n = 0; n < 2; ++n) { const int c = col0 + bj * 128 + n * 16; gv[bj][n] = *(const f32x4*)(gate + c) * w;
                gs[bj][n] = *(const f32x4*)(ng + c) * (*(const f32x4*)(nscale + c) + 1.f); }
        const int rowb = u.pm * 256 + wr * 64 + fr;
        const float* rb = (l == 0 && gidx == 2) ? (u.pm < 32 ? xp : xs - (size_t)MP * D) : out;
        f32x4 bn[2][2];
#pragma unroll
        for (int bj = 0; bj < 2; ++bj)
#pragma unroll
            for (int n = 0; n < 2; ++n) bn[bj][n] = *(const f32x4*)(rb + (size_t)rowb * D + col0 + bj * 128 + n * 16);
#pragma unroll
        for (int it = 0; it < 8; ++it) {
            const int ai = it >> 2, m = it & 3;
            const int row = rowb + ai * 128 + m * 16;
            float* op = out + (size_t)row * D; float ss = 0.f;
            f32x4 bc[2][2];
#pragma unroll
            for (int bj = 0; bj < 2; ++bj)
#pragma unroll
                for (int n = 0; n < 2; ++n) bc[bj][n] = bn[bj][n];
            if (it < 7) { const int rown = rowb + ((it + 1) >> 2) * 128 + ((it + 1) & 3) * 16;
#pragma unroll
                for (int bj = 0; bj < 2; ++bj)
#pragma unroll
                    for (int n = 0; n < 2; ++n) bn[bj][n] = *(const f32x4*)(rb + (size_t)rown * D + col0 + bj * 128 + n * 16); }
#pragma unroll
            for (int bj = 0; bj < 2; ++bj)
#pragma unroll
                for (int n = 0; n < 2; ++n) { const int c = col0 + bj * 128 + n * 16; const f32x4 o = bc[bj][n] + gv[bj][n] * acc[ai][bj][m][n]; *(f32x4*)(op + c) = o;
                    if (nn) { ss += (o[0] * o[0] + o[1] * o[1]) + (o[2] * o[2] + o[3] * o[3]); const f32x4 y = o * gs[bj][n]; u32x2 pw; pw.x = pk2(y[0], y[1]); pw.y = pk2(y[2], y[3]); *(u32x2*)(xn + (size_t)row * D + c) = pw; } }
            if (nn) { ss = xor32_sum(xor16_sum(ss)); if (fq == 0) atomicAdd(rss + row, ss); }
            __builtin_amdgcn_sched_barrier(0);
        }
    }
};
struct EpiQKV {
    static constexpr bool PERM = false, KWAIT = false;
    bf16_t *qk, *vt; float* out; const float* gtab; const float* rss; const float* sw;
    DI void operator()(const f32x4 (&acc)[2][2][4][2], const pg8::Unit& u, int wr, int wc, int fr, int fq) const {
        asm volatile("" : "+v"(fr), "+v"(fq));
        if (u.kind == 0) {
            const int slot = u.pn * 4 + wc;
            if (slot >= 26) return;
            const int type = slot < 8 ? 0 : slot < 16 ? 1 : slot < 24 ? 2 : 3;
            const int h = slot - (type == 0 ? 0 : type == 1 ? 8 : type == 2 ? 16 : 24);
            const float* g = gtab + type * 64;
            bf16_t* dst = qk + (size_t)slot * MTOK * 64;
            const float qs = (type == 0 || type == 2) ? 0.125f * LOG2E : 1.f;
            const bool rope = (type >= 2) && (u.pm >= 32);
            f32x4 gv[2][2];
#pragma unroll
            for (int bj = 0; bj < 2; ++bj)
#pragma unroll
                for (int n = 0; n < 2; ++n) gv[bj][n] = *(const f32x4*)(g + 32 * bj + 16 * n + 4 * fq);
            const int cond = u.pm < 32 ? 0 : 1 + ((u.pm - 32) >> 3);
            f32x4 sv[2][2];
#pragma unroll
            for (int bj = 0; bj < 2; ++bj)
#pragma unroll
                for (int n = 0; n < 2; ++n) sv[bj][n] = *(const f32x4*)(sw + cond * 2560 + u.pn * 256 + bj * 128 + wc * 32 + 16 * n + 4 * fq);
            float rs8[8];
#pragma unroll
            for (int it = 0; it < 8; ++it) rs8[it] = rss[u.pm * 256 + (it >> 2) * 128 + wr * 64 + (it & 3) * 16 + fr];
            float freq[4];
#pragma unroll
            for (int i = 0; i < 4; ++i) freq[i] = __builtin_amdgcn_exp2f(-(float)(4 * fq + i) * (0.0625f * 13.287712379549449f));
#pragma unroll
            for (int ai = 0; ai < 2; ++ai)
#pragma unroll
                for (int m = 0; m < 4; ++m) {
                    const int row = u.pm * 256 + ai * 128 + wr * 64 + m * 16 + fr;
                    f32x4 y[2][2]; float ss = 0.f; const float rin = rsqrtf(rs8[ai * 4 + m] * (1.f / D) + EPS);
#pragma unroll
                    for (int bj = 0; bj < 2; ++bj)
#pragma unroll
                        for (int n = 0; n < 2; ++n) { y[bj][n] = acc[ai][bj][m][n] * rin + sv[bj][n]; const f32x4 x = y[bj][n]; ss += (x[0] * x[0] + x[1] * x[1]) + (x[2] * x[2] + x[3] * x[3]); }
                    ss = xor32_sum(xor16_sum(ss));
                    const float rstd = rsqrtf(ss * (1.f / 64.f) + EPS);
#pragma unroll
                    for (int bj = 0; bj < 2; ++bj)
#pragma unroll
                        for (int n = 0; n < 2; ++n) y[bj][n] = y[bj][n] * rstd * gv[bj][n];
                    if (rope) {
                        const int t = (row - MP) & 2047;
#pragma unroll
                        for (int bj = 0; bj < 2; ++bj) {
                            const float pos = (float)(bj == 0 ? (t >> 6) : (t & 63));
#pragma unroll
                            for (int i = 0; i < 4; ++i) {
                                const float ang = pos * freq[i]; const float sn = __sinf(ang), cs = __cosf(ang);
                                const float x1 = y[bj][0][i], x2 = y[bj][1][i];
                                y[bj][0][i] = x1 * cs - x2 * sn; y[bj][1][i] = x1 * sn + x2 * cs;
                            }
                        }
                    }
                    if (u.pm < 32 && (type == 1 || type == 3)) {
                        const size_t oo = (type == 1 ? O_NAK + (size_t)row * 512 : O_GK + (size_t)row * 128) + h * 64;
                        float* o = out + oo;
#pragma unroll
                        for (int bj = 0; bj < 2; ++bj)
#pragma unroll
                            for (int n = 0; n < 2; ++n) __builtin_nontemporal_store(y[bj][n], (f32x4*)(o + 32 * bj + 16 * n + 4 * fq));
                    }
                    bf16_t* dp = dst + (size_t)row * 64 + 4 * fq;
#pragma unroll
                    for (int bj = 0; bj < 2; ++bj)
#pragma unroll
                        for (int n = 0; n < 2; ++n) { const f32x4 v = y[bj][n] * qs; u32x2 w; w.x = pk2(v[0], v[1]); w.y = pk2(v[2], v[3]); *(u32x2*)(dp + 32 * bj + 16 * n) = w; }
                    __builtin_amdgcn_sched_barrier(0);
                }
        } else {
            const int condt = u.pn < 32 ? 0 : 1 + ((u.pn - 32) >> 3);
            f32x4 rt[2][2]; float sw8[8];
#pragma unroll
            for (int bj = 0; bj < 2; ++bj)
#pragma unroll
                for (int n = 0; n < 2; ++n) { const f32x4 q4 = *(const f32x4*)(rss + u.pn * 256 + bj * 128 + wc * 32 + 16 * n + 4 * fq);
#pragma unroll
                    for (int i = 0; i < 4; ++i) rt[bj][n][i] = rsqrtf(q4[i] * (1.f / D) + EPS); }
#pragma unroll
            for (int it = 0; it < 8; ++it) { const int dv = u.pm * 256 + (it >> 2) * 128 + wr * 64 + (it & 3) * 16 + fr; sw8[it] = sw[condt * 2560 + 1792 + (dv < 768 ? dv : 0)]; }
#pragma unroll
            for (int ai = 0; ai < 2; ++ai)
#pragma unroll
                for (int m = 0; m < 4; ++m) {
                    const int dv = u.pm * 256 + ai * 128 + wr * 64 + m * 16 + fr;
                    if (dv < 640) {
                        const float swv = sw8[ai * 4 + m];
#pragma unroll
                        for (int bj = 0; bj < 2; ++bj)
#pragma unroll
                            for (int n = 0; n < 2; ++n) {
                                const int tok0 = u.pn * 256 + bj * 128 + wc * 32 + 16 * n + 4 * fq;
                                const f32x4 v = acc[ai][bj][m][n] * rt[bj][n] + swv;
                                u32x2 w; w.x = pk2(v[0], v[1]); w.y = pk2(v[2], v[3]);
                                *(u32x2*)(vt + (size_t)dv * MTOK + tok0) = w;
                                if (u.pn < 32) {
                                    if (dv < 512) { float* o = out + O_NAV + (size_t)tok0 * 512 + dv; __builtin_nontemporal_store(v[0], o); __builtin_nontemporal_store(v[1], o + 512); __builtin_nontemporal_store(v[2], o + 1024); __builtin_nontemporal_store(v[3], o + 1536); }
                                    else { float* o = out + O_GV + (size_t)tok0 * 128 + (dv - 512); __builtin_nontemporal_store(v[0], o); __builtin_nontemporal_store(v[1], o + 128); __builtin_nontemporal_store(v[2], o + 256); __builtin_nontemporal_store(v[3], o + 384); }
                                }
                            }
                    }
                    __builtin_amdgcn_sched_barrier(0);
                }
        }
    }
};
struct EpiSGU {
    static constexpr bool PERM = true, KWAIT = false; bf16_t* U; bf16_t* VTS; float* rowss; const float* rss; const float* sw;
    DI void operator()(const f32x4 (&acc)[2][2][4][2], const pg8::Unit& u, int wr, int wc, int fr, int fq) const {
        asm volatile("" : "+v"(fr), "+v"(fq));
        const int r0 = u.pm * 256 + wr * 64 + fr, c0 = u.pn * 256 + wc * 32 + 8 * fq;
        bf16_t* base = u.kind ? VTS : U; const size_t ld = u.kind ? (size_t)MTOK : (size_t)2048;
        const int condc = u.kind ? (u.pn < 32 ? 0 : 1 + ((u.pn - 32) >> 3)) : (u.pm < 32 ? 0 : 1 + ((u.pm - 32) >> 3));
        f32x4 cs[2][2];
#pragma unroll
        for (int bj = 0; bj < 2; ++bj)
#pragma unroll
            for (int n = 0; n < 2; ++n) {
                if (u.kind == 0) cs[bj][n] = *(const f32x4*)(sw + condc * 4096 + c0 + bj * 128 + 4 * n);
                else { const f32x4 q4 = *(const f32x4*)(rss + c0 + bj * 128 + 4 * n);
#pragma unroll
                    for (int i = 0; i < 4; ++i) cs[bj][n][i] = rsqrtf(q4[i] * (1.f / D) + EPS); }
            }
        f32x4 sq[2][2];
#pragma unroll
        for (int bj = 0; bj < 2; ++bj)
#pragma unroll
            for (int n = 0; n < 2; ++n) sq[bj][n] = (f32x4){0.f, 0.f, 0.f, 0.f};
        float rs8[8];
#pragma unroll
        for (int it = 0; it < 8; ++it) { const int row = r0 + (it >> 2) * 128 + (it & 3) * 16; rs8[it] = u.kind ? sw[condc * 4096 + 2048 + row] : rss[row]; }
#pragma unroll
        for (int ai = 0; ai < 2; ++ai)
#pragma unroll
            for (int m = 0; m < 4; ++m) {
                const int row = r0 + ai * 128 + m * 16;
                const float rsc = u.kind ? rs8[ai * 4 + m] : rsqrtf(rs8[ai * 4 + m] * (1.f / D) + EPS);
                bf16_t* rowp = base + (size_t)row * ld + c0;
#pragma unroll
                for (int bj = 0; bj < 2; ++bj) {
                    const f32x4 x0 = u.kind ? acc[ai][bj][m][0] * cs[bj][0] + rsc : acc[ai][bj][m][0] * rsc + cs[bj][0];
                    const f32x4 x1 = u.kind ? acc[ai][bj][m][1] * cs[bj][1] + rsc : acc[ai][bj][m][1] * rsc + cs[bj][1];
                    const f32x4 a = gelu4(x0), b = gelu4(x1);
                    sq[bj][0] += a * a; sq[bj][1] += b * b;
                    u32x4 w; w.x = pk2(a[0], a[1]); w.y = pk2(a[2], a[3]); w.z = pk2(b[0], b[1]); w.w = pk2(b[2], b[3]); *(u32x4*)(rowp + bj * 128) = w; }
                __builtin_amdgcn_sched_barrier(0);
            }
        if (u.kind) {
#pragma unroll
            for (int bj = 0; bj < 2; ++bj)
#pragma unroll
                for (int n = 0; n < 2; ++n)
#pragma unroll
                    for (int i = 0; i < 4; ++i) {
                        float s = sq[bj][n][i];
                        s = row16_sum(s);
                        if (fr == 0) atomicAdd(rowss + c0 + bj * 128 + 4 * n + i, s);
                    }
        }
    }
};

struct TItem { const float* src; bf16_t* dst0; bf16_t* dst1; int ldw, Kd; };
DI void titem_load(const TItem& t, int lane, float (&v)[64]) {
#pragma unroll
    for (int i = 0; i < 64; ++i) v[i] = __builtin_nontemporal_load(t.src + (size_t)i * t.ldw + lane);
}
DI void titem_finish(const TItem& t, LAS float* scr, int lane, const float (&v)[64]) {
#pragma unroll
    for (int i = 0; i < 64; ++i) scr[i * 65 + lane] = v[i];
    asm volatile("s_waitcnt lgkmcnt(0)" ::: "memory");
    const int c = lane & 7;
#pragma unroll
    for (int j = 0; j < 8; ++j) { const int n = (lane >> 3) + 8 * j; const LAS float* s = scr + (8 * c) * 65 + n;
        u32x4 o; o.x = pk2(s[0 * 65], s[1 * 65]); o.y = pk2(s[2 * 65], s[3 * 65]); o.z = pk2(s[4 * 65], s[5 * 65]); o.w = pk2(s[6 * 65], s[7 * 65]);
        bf16_t* d = (j < 4 ? t.dst0 + (size_t)n * t.Kd : t.dst1 + (size_t)(n - 32) * t.Kd) + 8 * c;
        *(u32x4*)d = o; }
    asm volatile("s_waitcnt lgkmcnt(0)" ::: "memory");
}
DI void convert_list(const Params& p, unsigned char* ws, LAS unsigned char* lds, int mask, int gw, int ngw, int wid, int lane) {
    LAS float* scr = (LAS float*)(lds + wid * 16640);
    int NIT = 0;
#pragma unroll
    for (int m = 0; m < 12; ++m) { const int cnt = m < 4 ? 1408 : m < 8 ? 704 : m == 8 ? 576 : m == 9 ? 256 : m == 10 ? 1024 : 512; if ((mask >> m) & 1) NIT += cnt; }
    auto decode = [&](int a, TItem& t) {
        int mm = 0, r = a; bool found = false;
#pragma unroll
        for (int m = 0; m < 12; ++m) { const int cnt = m < 4 ? 1408 : m < 8 ? 704 : m == 8 ? 576 : m == 9 ? 256 : m == 10 ? 1024 : 512;
            if (!found && ((mask >> m) & 1)) { if (r < cnt) { mm = m; found = true; } else r -= cnt; } }
        const float* W; bf16_t* WT; int ldw, Kd, k0, n0, drow0, drow1;
        if (mm < 4) { const int mi = mm, l = mi >> 1, f = mi & 1;
            W = (f ? p.in[13] : p.in[11]) + (size_t)l * D * 5632; const int kb = r / 88, nb = r % 88; n0 = nb * 64; k0 = kb * 64; ldw = 5632; Kd = D;
            drow0 = n0 < FH ? (n0 >> 7) * 256 + (n0 & 127) : ((n0 - FH) >> 7) * 256 + 128 + ((n0 - FH) & 127); drow1 = drow0 + 32;
            WT = (bf16_t*)(ws + WS_W + (size_t)mi * FFN_STRIDE); }
        else if (mm < 8) { const int mi = mm - 4, l = mi >> 1, f = mi & 1;
            W = (f ? p.in[14] : p.in[12]) + (size_t)l * FH * D; const int kb = r / 16, nb = r % 16; n0 = nb * 64; k0 = kb * 64; ldw = D; Kd = FH; drow0 = n0; drow1 = n0 + 32;
            WT = (bf16_t*)(ws + WS_W + (size_t)mi * FFN_STRIDE + FFN_DOWN); }
        else if (mm == 8) { const int kb = r / 36, slot = r % 36; n0 = slot * 64; k0 = kb * 64; ldw = 2304; Kd = D; W = p.in[15];
            if (slot >= 16 && slot < 24) { WT = (bf16_t*)(ws + WS_WV); drow0 = (slot - 16) * 64; drow1 = drow0 + 32; }
            else if (slot >= 34) { WT = (bf16_t*)(ws + WS_WV); drow0 = 512 + (slot - 34) * 64; drow1 = drow0 + 32; }
            else { const int q = slot < 16 ? slot : slot - 8; WT = (bf16_t*)(ws + WS_WQK); drow0 = (q >> 2) * 256 + 32 * (q & 3); drow1 = drow0 + 128; } }
        else if (mm == 9) { const int kb = r / 16, nb = r % 16; n0 = nb * 64; k0 = kb * 64; ldw = D; Kd = D; W = p.in[16]; WT = (bf16_t*)(ws + WS_WO); drow0 = n0; drow1 = n0 + 32; }
        else if (mm == 10) { const int kb = r / 64, nb = r % 64; n0 = nb * 64; k0 = kb * 64; ldw = 4096; Kd = D; W = p.in[22]; WT = (bf16_t*)(ws + WS_WSI); drow0 = n0; drow1 = n0 + 32; }
        else { const int kb = r / 16, nb = r % 16; n0 = nb * 64; k0 = kb * 64; ldw = D; Kd = 2048; W = p.in[26]; WT = (bf16_t*)(ws + WS_WSO); drow0 = n0; drow1 = n0 + 32; }
        t.src = W + (size_t)k0 * ldw + n0; t.dst0 = WT + (size_t)drow0 * Kd + k0; t.dst1 = WT + (size_t)drow1 * Kd + k0; t.ldw = ldw; t.Kd = Kd;
    };
    for (int it = gw; it < NIT; it += ngw) { TItem cur; float vc[64]; decode(it, cur); titem_load(cur, lane, vc); titem_finish(cur, scr, lane, vc); }
}
DI void mod_gemv(const Params& p, unsigned char* ws, LAS unsigned char* lds, int l_lo, int l_hi, int gw, int ngw, int tid, int lane) {
    LAS float* silu = (LAS float*)lds;
    for (int i = tid; i < 3072; i += 512) { const int ci = i >> 10, k = i & 1023; const float x = ci == 0 ? p.in[7][k] : p.in[6][(ci - 1) * D + k]; silu[i] = x / (1.f + __expf(-x)); }
    __syncthreads();
    float* mod = (float*)(ws + WS_MOD);
    const int ntask = (l_hi - l_lo) * 4608;
    for (int id = gw; id < ntask; id += ngw) {
        const int l = l_lo + id / 4608, r = id % 4608, kc = r / 144, st = r - kc * 144, n0 = st * 64, k0 = kc * 32;
        const float* w = p.in[9] + (size_t)l * D * NMOD + (size_t)k0 * NMOD + n0 + lane;
        float wv[32];
#pragma unroll
        for (int kk = 0; kk < 32; ++kk) wv[kk] = __builtin_nontemporal_load(w + (size_t)kk * NMOD);
        float a0 = 0.f, a1 = 0.f, a2 = 0.f;
#pragma unroll
        for (int kk = 0; kk < 32; ++kk) { a0 += silu[k0 + kk] * wv[kk]; a1 += silu[1024 + k0 + kk] * wv[kk]; a2 += silu[2048 + k0 + kk] * wv[kk]; }
        if (kc == 0) { const float bb = p.in[10][l * NMOD + n0 + lane]; a0 += bb; a1 += bb; a2 += bb; }
        atomicAdd(mod + (size_t)(l * 3 + 0) * NMOD + n0 + lane, a0); atomicAdd(mod + (size_t)(l * 3 + 1) * NMOD + n0 + lane, a1); atomicAdd(mod + (size_t)(l * 3 + 2) * NMOD + n0 + lane, a2);
    }
    __syncthreads();
}
DI void conv_caches(const Params& p, unsigned char* ws, int gt, int nth) {
    bf16_t* kcna = (bf16_t*)(ws + WS_KCNA); bf16_t* vcnat = (bf16_t*)(ws + WS_VCNAT); bf16_t* kcg = (bf16_t*)(ws + WS_KCG); bf16_t* vcgt = (bf16_t*)(ws + WS_VCGT);
    for (int i = gt; i < 524288; i += nth) {
        { const int d = i & 63, l = (i >> 6) & 511, h = (i >> 15) & 7, b = i >> 18; kcna[i] = (bf16_t)pk2(p.in[2][((size_t)(b * 512 + l) * 8 + h) * 64 + d], 0.f); }
        { const int l = i & 511, d = (i >> 9) & 63, h = (i >> 15) & 7, b = i >> 18; vcnat[i] = (bf16_t)pk2(p.in[3][((size_t)(b * 512 + l) * 8 + h) * 64 + d], 0.f); }
    }
    for (int i = gt; i < 131072; i += nth) {
        { const int d = i & 63, l = (i >> 6) & 511, kv = (i >> 15) & 1, b = i >> 16; kcg[i] = (bf16_t)pk2(p.in[4][((size_t)(b * 512 + l) * 2 + kv) * 64 + d], 0.f); }
        { const int l = i & 511, d = (i >> 9) & 63, kv = (i >> 15) & 1, b = i >> 16; vcgt[i] = (bf16_t)pk2(p.in[5][((size_t)(b * 512 + l) * 2 + kv) * 64 + d], 0.f); }
    }
}
DI void prep_phase(const Params& p, unsigned char* ws, LAS unsigned char* lds, int tid, int wid, int lane, int cb, int G) {
    mod_gemv(p, ws, lds, 0, G > 192 ? 1 : 2, cb * 8 + wid, G * 8, tid, lane);
    {
        const int gt = cb * 512 + tid, nth = G * 512;
        if (G <= 192) conv_caches(p, ws, gt, nth);
        unsigned* z0a = (unsigned*)(ws + WS_WQK + (size_t)1600 * D * 2); unsigned* z0b = (unsigned*)(ws + WS_WQK + (size_t)1728 * D * 2); unsigned* z1 = (unsigned*)(ws + WS_WV + (size_t)640 * D * 2);
        for (int i = gt; i < 65536; i += nth) { if (i < 32768) z0a[i] = 0u; else z0b[i - 32768] = 0u; z1[i] = 0u; }
        if (gt < 256) { const int ty = gt >> 6, d = gt & 63; ((float*)(ws + WS_GTAB))[gt] = ty == 0 ? p.in[17][d] : ty == 1 ? p.in[18][d] : ty == 2 ? p.in[20][d] : p.in[21][d]; }
    }
    convert_list(p, ws, lds, G > 192 ? 0x111 : 0xfff, cb * 8 + wid, G * 8, wid, lane);
}

DI void sw_rows(const Params& p, unsigned char* ws, int sel, int gw, int ngw, int lane) {
    float* swb = (float*)(ws + WS_SW); const float* mod = (const float*)(ws + WS_MOD);
#pragma unroll 1
    for (int ci = 0; ci < 7; ++ci) {
        if (!((sel >> ci) & 1)) continue;
        const bf16_t* W; int l, j, nrows, cstride; float* o;
        if (ci < 4) { W = (const bf16_t*)(ws + WS_W + (size_t)ci * FFN_STRIDE); l = ci >> 1; j = (ci & 1) ? 2 : 0; o = swb + ci * 3 * 5632; cstride = 5632; nrows = 5632; }
        else if (ci == 4) { W = (const bf16_t*)(ws + WS_WQK); l = 0; j = 1; o = swb + SW_QKV; cstride = 2560; nrows = 1792; }
        else if (ci == 5) { W = (const bf16_t*)(ws + WS_WV); l = 0; j = 1; o = swb + SW_QKV + 1792; cstride = 2560; nrows = 768; }
        else { W = (const bf16_t*)(ws + WS_WSI); l = 1; j = 1; o = swb + SW_SGU; cstride = 4096; nrows = 4096; }
        f32x4 sh[3][4];
#pragma unroll
        for (int c = 0; c < 3; ++c)
#pragma unroll
            for (int q = 0; q < 4; ++q) sh[c][q] = *(const f32x4*)(mod + (size_t)(l * 3 + c) * NMOD + 3 * j * D + lane * 16 + 4 * q);
        for (int row = gw; row < nrows; row += ngw) {
            const u32x4 w0 = *(const u32x4*)(W + (size_t)row * D + lane * 16), w1 = *(const u32x4*)(W + (size_t)row * D + lane * 16 + 8);
            float wf[16];
#pragma unroll
            for (int i = 0; i < 4; ++i) { wf[2 * i] = __builtin_bit_cast(float, w0[i] << 16); wf[2 * i + 1] = __builtin_bit_cast(float, w0[i] & 0xffff0000u);
                                          wf[8 + 2 * i] = __builtin_bit_cast(float, w1[i] << 16); wf[8 + 2 * i + 1] = __builtin_bit_cast(float, w1[i] & 0xffff0000u); }
            float a3[3];
#pragma unroll
            for (int c = 0; c < 3; ++c) { float a = 0.f;
#pragma unroll
                for (int q = 0; q < 4; ++q) a += (wf[4 * q] * sh[c][q][0] + wf[4 * q + 1] * sh[c][q][1]) + (wf[4 * q + 2] * sh[c][q][2] + wf[4 * q + 3] * sh[c][q][3]);
                a3[c] = wave_sum(a); }
            if (lane < 3) o[lane * cstride + row] = lane == 0 ? a3[0] : lane == 1 ? a3[1] : a3[2];
        }
    }
}

DI void phase1(const Params& p, unsigned char* ws, int gw, int ngw, int lane) {
    const float* mod = (const float*)(ws + WS_MOD);
    {
        const float* g = p.in[8];
        bf16_t* xn = (bf16_t*)(ws + WS_XN); float* rss0 = (float*)(ws + WS_CTL + WS_RSS);
        for (int m = gw; m < MTOK; m += ngw) {
            const int cond = m < MP ? 0 : 1 + ((m - MP) >> 11);
            const float* row = m < MP ? p.in[0] + (size_t)m * D : p.in[1] + (size_t)(m - MP) * D;
            const float* sc = mod + (cond * 9 + 1) * D;
            f32x4 v[4]; float ss = 0.f;
#pragma unroll
            for (int jj = 0; jj < 4; ++jj) { v[jj] = __builtin_nontemporal_load((const f32x4*)(row + 4 * lane + 256 * jj)); ss += (v[jj][0] * v[jj][0] + v[jj][1] * v[jj][1]) + (v[jj][2] * v[jj][2] + v[jj][3] * v[jj][3]); }
            ss = wave_sum(ss);
            if (lane == 0) rss0[m] = ss;
#pragma unroll
            for (int jj = 0; jj < 4; ++jj) { const int col = 4 * lane + 256 * jj;
                const f32x4 gg = *(const f32x4*)(g + col), s1 = *(const f32x4*)(sc + col);
                const f32x4 y = v[jj] * gg * (s1 + 1.f);
                u32x2 w; w.x = pk2(y[0], y[1]); w.y = pk2(y[2], y[3]); *(u32x2*)(xn + (size_t)m * D + col) = w; }
        }
    }
    sw_rows(p, ws, ngw > 1536 ? 0x31 : 0x7f, gw, ngw, lane);
}

#define MFMA32(a, b, c) __builtin_amdgcn_mfma_f32_32x32x16_bf16((a), (b), (c), 0, 0, 0)
constexpr int AT_ROW = 144;
constexpr int AT_KBUF = 0, AT_VBUF = 2 * 64 * AT_ROW, AT_RPB = 4 * 64 * AT_ROW, AT_TASK = AT_RPB + 2048;
struct ATask { const bf16_t* k0; const bf16_t* vt0; const bf16_t* kc; const bf16_t* vtc; int type, nsteps, urow0; };
DI void at_src(const ATask& T, int u, const bf16_t*& k, const bf16_t*& vt, int& vld) {
    if (T.type == 0) { k = T.k0 + (size_t)u * 4096; vt = T.vt0 + u * 64; vld = MTOK; }
    else if (T.type == 1) { if (u < 32) { k = T.k0 + (size_t)u * 4096; vt = T.vt0 + u * 64; vld = MTOK; } else { k = T.kc + (size_t)(u - 32) * 4096; vt = T.vtc + (u - 32) * 64; vld = 512; } }
    else { if (u < 8) { k = T.kc + (size_t)u * 4096; vt = T.vtc + u * 64; vld = 512; } else { const int tok = (T.urow0 + (u - 8)) * 64; k = T.k0 + (size_t)tok * 64; vt = T.vt0 + tok; vld = MTOK; } }
}
DI void at_gload(const ATask& T, int u, int tid, u32x4& a, u32x4& b) {
    const bf16_t* k; const bf16_t* vt; int vld; at_src(T, u, k, vt, vld);
    if (tid < 256) { const bf16_t* p = k + (tid >> 3) * 64 + (tid & 7) * 8; a = *(const u32x4*)p; b = *(const u32x4*)(p + 32 * 64); }
    else { const int j = tid - 256; const bf16_t* p = vt + (size_t)(j >> 2) * vld + (j & 3) * 8; a = *(const u32x4*)p; b = *(const u32x4*)(p + 32); }
}
DI void at_lstore(LAS unsigned char* lds, int buf, int tid, u32x4 a, u32x4 b) {
    if (tid < 256) { LAS unsigned char* p = lds + AT_KBUF + buf * 64 * AT_ROW + (tid >> 3) * AT_ROW + (tid & 7) * 16; *(LAS u32x4*)p = a; *(LAS u32x4*)(p + 32 * AT_ROW) = b; }
    else { const int j = tid - 256, c = j & 3, s = c >> 1, sec = c & 1; LAS unsigned char* row = lds + AT_VBUF + buf * 64 * AT_ROW + (j >> 2) * AT_ROW;
        const int o0 = ((s * 2 + 0) * 2 + sec) * 8, o1 = ((s * 2 + 1) * 2 + sec) * 8;
        *(LAS u32x2*)(row + o0) = (u32x2){a.x, a.y}; *(LAS u32x2*)(row + o1) = (u32x2){a.z, a.w};
        *(LAS u32x2*)(row + 64 + o0) = (u32x2){b.x, b.y}; *(LAS u32x2*)(row + 64 + o1) = (u32x2){b.z, b.w}; }
}
DI void attn_phase(const Params& p, unsigned char* ws, LAS unsigned char* lds, int tid, int wid, int lane, int rep) {
    unsigned char* R = ws + WS_R;
    const bf16_t* QNA = (const bf16_t*)(R + R_QNA); const bf16_t* KNA = (const bf16_t*)(R + R_KNA); const bf16_t* QG = (const bf16_t*)(R + R_QG); const bf16_t* KG = (const bf16_t*)(R + R_KG);
    const bf16_t* VT = (const bf16_t*)(R + R_VT); bf16_t* AO = (bf16_t*)(R + R_AO);
    const bf16_t* KCNA = (const bf16_t*)(ws + WS_KCNA); const bf16_t* VCNAT = (const bf16_t*)(ws + WS_VCNAT); const bf16_t* KCG = (const bf16_t*)(ws + WS_KCG); const bf16_t* VCGT = (const bf16_t*)(ws + WS_VCGT);
    unsigned* counter = (unsigned*)(ws + WS_CTL) + 64 * rep;
    LAS float* rpb_l = (LAS float*)(lds + AT_RPB); volatile LAS int* taskw = (volatile LAS int*)(lds + AT_TASK);
    const int r32 = lane & 31, hi = lane >> 5;
    for (;;) {
        if (tid == 0) taskw[0] = (int)atomicAdd(counter, 1u);
        __syncthreads();
        const int t = __builtin_amdgcn_readfirstlane(taskw[0]);
        if (t >= 768) break;
        ATask T; T.kc = nullptr; T.vtc = nullptr; T.urow0 = 0;
        const bf16_t* q; bf16_t* o; int r = 0, cblk = 0, row0 = 0;
        if (t < 128) {
            const int b = t >> 6, kv = (t >> 5) & 1, grp = t & 31, qh = kv * 4 + (grp >> 3), qb = (grp & 7) * 8 + wid, tok0 = MP + b * 2048;
            q = QG + ((size_t)qh * MTOK + tok0 + qb * 32) * 64; T.k0 = KG + ((size_t)kv * MTOK + tok0) * 64; T.vt0 = VT + (size_t)(512 + kv * 64) * MTOK + tok0;
            T.kc = KCG + (size_t)((b * 2 + kv) * 512) * 64; T.vtc = VCGT + (size_t)((b * 2 + kv) * 64) * 512; o = AO + (size_t)(tok0 + qb * 32) * D + 512 + qh * 64; T.type = 1; T.nsteps = 40;
        } else if (t < 256) {
            const int i = t - 128, b = i >> 6, h = (i >> 3) & 7, rg = i & 7, tok0 = MP + b * 2048;
            r = 4 * rg + (wid >> 1); cblk = wid & 1; row0 = min(max(r - 4, 0), 24);
            T.urow0 = min(max(4 * rg - 4, 0), 24); const int urow1 = min(max(4 * rg - 1, 0), 24) + 7;
            const int qb = r * 2 + cblk;
            q = QNA + ((size_t)h * MTOK + tok0 + qb * 32) * 64; T.k0 = KNA + ((size_t)h * MTOK + tok0) * 64; T.vt0 = VT + (size_t)(h * 64) * MTOK + tok0;
            T.kc = KCNA + (size_t)((b * 8 + h) * 512) * 64; T.vtc = VCNAT + (size_t)((b * 8 + h) * 64) * 512; o = AO + (size_t)(tok0 + qb * 32) * D + h * 64; T.type = 2; T.nsteps = 8 + (urow1 - T.urow0 + 1);
            if (tid < 465) rpb_l[tid] = p.in[19][h * 465 + tid] * LOG2E;
        } else {
            const int i = t - 256, isB = i >> 8, j = i & 255, b = j >> 3, h = j & 7, tok0 = b * 256, qb = wid;
            if (!isB) { q = QNA + ((size_t)h * MTOK + tok0 + qb * 32) * 64; T.k0 = KNA + ((size_t)h * MTOK + tok0) * 64; T.vt0 = VT + (size_t)(h * 64) * MTOK + tok0; o = AO + (size_t)(tok0 + qb * 32) * D + h * 64; }
            else { const int kv = h >> 2; q = QG + ((size_t)h * MTOK + tok0 + qb * 32) * 64; T.k0 = KG + ((size_t)kv * MTOK + tok0) * 64; T.vt0 = VT + (size_t)(512 + kv * 64) * MTOK + tok0; o = AO + (size_t)(tok0 + qb * 32) * D + 512 + h * 64; }
            T.type = 0; T.nsteps = 4;
        }
        const int ns = T.nsteps;
        u32x4 pa, pb, pc, pd; at_gload(T, 0, tid, pc, pd); at_gload(T, 1, tid, pa, pb);
        bf16x8 qf[4];
#pragma unroll
        for (int ks = 0; ks < 4; ++ks) qf[ks] = *(const bf16x8*)(q + r32 * 64 + ks * 16 + hi * 8);
        at_lstore(lds, 0, tid, pc, pd);
        float mrun = -1e30f, lrun = 0.f; f32x16 o0, o1;
#pragma unroll
        for (int i = 0; i < 16; ++i) { o0[i] = 0.f; o1[i] = 0.f; }
        __syncthreads();
        for (int u = 0; u < ns; ++u) {
            if (u + 1 < ns) at_lstore(lds, (u + 1) & 1, tid, pa, pb);
            if (u + 2 < ns) at_gload(T, u + 2, tid, pa, pb);
            bool active = true; const bool local = (T.type == 2 && u >= 8); int kr = 0;
            if (local) { kr = T.urow0 + (u - 8); active = (kr >= row0) && (kr < row0 + 8); }
            if (active) {
                const LAS unsigned char* kb = lds + AT_KBUF + (u & 1) * 64 * AT_ROW + r32 * AT_ROW + hi * 16;
                const LAS unsigned char* vb = lds + AT_VBUF + (u & 1) * 64 * AT_ROW + r32 * AT_ROW + hi * 16;
                f32x16 st[2];
#pragma unroll
                for (int h2 = 0; h2 < 2; ++h2) {
                    bf16x8 kf[4];
#pragma unroll
                    for (int ks = 0; ks < 4; ++ks) kf[ks] = *(const LAS bf16x8*)(kb + h2 * 32 * AT_ROW + ks * 32);
#pragma unroll
                    for (int i = 0; i < 16; ++i) st[h2][i] = 0.f;
#pragma unroll
                    for (int ks = 0; ks < 4; ++ks) st[h2] = MFMA32(kf[ks], qf[ks], st[h2]);
                }
                if (local) {
                    const int dr = kr - r + 7; const int qc = 32 * cblk + r32; const int wsq = min(max(qc - 8, 0), 48);
#pragma unroll
                    for (int h2 = 0; h2 < 2; ++h2) {
                        const int base = dr * 31 + 15 - qc + 32 * h2 + 4 * hi;
#pragma unroll
                        for (int i = 0; i < 16; ++i) { const int ko = (i & 3) + 8 * (i >> 2); const int kc = 32 * h2 + 4 * hi + ko; const bool ok = (kc >= wsq) && (kc < wsq + 16);
                            const float bias = rpb_l[ok ? base + ko : 0]; st[h2][i] = ok ? st[h2][i] + bias : -1e30f; }
                    }
                }
                float mx = fmaxf(fmaxf(st[0][0], st[0][1]), fmaxf(st[1][0], st[1][1]));
#pragma unroll
                for (int i = 2; i < 16; i += 2) mx = fmaxf(mx, fmaxf(fmaxf(st[0][i], st[0][i + 1]), fmaxf(st[1][i], st[1][i + 1])));
                mx = xor32_max(mx);
                if (__any(mx > mrun)) {
                    const float mnew = fmaxf(mrun, mx), alpha = __builtin_amdgcn_exp2f(mrun - mnew); mrun = mnew;
                    lrun *= alpha;
#pragma unroll
                    for (int i = 0; i < 16; ++i) { o0[i] *= alpha; o1[i] *= alpha; }
                }
                float ps0 = 0.f, ps1 = 0.f;
#pragma unroll
                for (int i = 0; i < 16; ++i) { st[0][i] = __builtin_amdgcn_exp2f(st[0][i] - mrun); ps0 += st[0][i]; st[1][i] = __builtin_amdgcn_exp2f(st[1][i] - mrun); ps1 += st[1][i]; }
                lrun += ps0 + ps1;
#pragma unroll
                for (int h2 = 0; h2 < 2; ++h2) {
                    u32x4 p0, p1;
                    p0.x = pk2(st[h2][0], st[h2][1]); p0.y = pk2(st[h2][2], st[h2][3]); p0.z = pk2(st[h2][4], st[h2][5]); p0.w = pk2(st[h2][6], st[h2][7]);
                    p1.x = pk2(st[h2][8], st[h2][9]); p1.y = pk2(st[h2][10], st[h2][11]); p1.z = pk2(st[h2][12], st[h2][13]); p1.w = pk2(st[h2][14], st[h2][15]);
                    const bf16x8 pf0 = __builtin_bit_cast(bf16x8, p0), pf1 = __builtin_bit_cast(bf16x8, p1);
                    bf16x8 vf[4];
#pragma unroll
                    for (int db = 0; db < 2; ++db)
#pragma unroll
                        for (int s = 0; s < 2; ++s) vf[db * 2 + s] = *(const LAS bf16x8*)(vb + db * 32 * AT_ROW + h2 * 64 + s * 32);
                    o0 = MFMA32(vf[0], pf0, o0); o0 = MFMA32(vf[1], pf1, o0);
                    o1 = MFMA32(vf[2], pf0, o1); o1 = MFMA32(vf[3], pf1, o1);
                }
            }
            __syncthreads();
        }
        lrun = xor32_sum(lrun);
        const float inv = 1.f / lrun;
        bf16_t* op = o + (size_t)r32 * D + 4 * hi;
#pragma unroll
        for (int gq = 0; gq < 4; ++gq) {
            u32x2 w0, w1;
            w0.x = pk2(o0[4 * gq] * inv, o0[4 * gq + 1] * inv); w0.y = pk2(o0[4 * gq + 2] * inv, o0[4 * gq + 3] * inv);
            w1.x = pk2(o1[4 * gq] * inv, o1[4 * gq + 1] * inv); w1.y = pk2(o1[4 * gq + 2] * inv, o1[4 * gq + 3] * inv);
            *(u32x2*)(op + 8 * gq) = w0; *(u32x2*)(op + 32 + 8 * gq) = w1;
        }
    }
}

DI void spatial_phase(const Params& p, unsigned char* ws, LAS unsigned char* lds, int tid, int wid, int lane, int cb, int G) {
    unsigned char* R = ws + WS_R;
    bf16_t* U = (bf16_t*)(R + R_U); const bf16_t* VTS = (const bf16_t*)(R + R_VTS);
    const float* rowss = (const float*)(ws + WS_CTL + 4096);
    const float* Ws = p.in[24]; const float* bs = p.in[25]; const float* vg = p.in[23];
    const int r32 = lane & 31, hi = lane >> 5, tb = wid & 3, dh = wid >> 2;
    for (int unit = cb; unit < 768; unit += G) {
        const int c = unit >> 3, g = unit & 7;
        const int t = 128 * c + 32 * tb + r32;
        u32x4 stg[8];
#pragma unroll
        for (int j = 0; j < 8; ++j) stg[j] = *(const u32x4*)(VTS + (size_t)(256 * g + (tid >> 4) + 32 * j) * MTOK + 128 * c + (tid & 15) * 8);
        f32x4 wst[8];
#pragma unroll
        for (int j = 0; j < 8; ++j) wst[j] = *(const f32x4*)(Ws + ((size_t)g * 128 + (tid >> 5) + 16 * j) * 128 + (tid & 31) * 4);
        const f32x4 rq = *(const f32x4*)(rowss + 128 * c + (tid & 31) * 4);
        u32x2 uu[4][4];
#pragma unroll
        for (int db = 0; db < 4; ++db)
#pragma unroll
            for (int gq = 0; gq < 4; ++gq) uu[db][gq] = *(const u32x2*)(U + (size_t)t * 2048 + 256 * g + 128 * dh + 32 * db + 8 * gq + 4 * hi);
        __syncthreads();
#pragma unroll
        for (int j = 0; j < 8; ++j) *(LAS u32x4*)(lds + ((tid >> 4) + 32 * j) * 272 + (tid & 15) * 16) = stg[j];
        { f32x4 r4;
#pragma unroll
          for (int i = 0; i < 4; ++i) r4[i] = rsqrtf(rq[i] * (1.f / 2048.f) + EPS);
#pragma unroll
          for (int j = 0; j < 8; ++j) { const f32x4 w = wst[j] * r4; u32x2 pw; pw.x = pk2(w[0], w[1]); pw.y = pk2(w[2], w[3]); *(LAS u32x2*)(lds + 69632 + ((tid >> 5) + 16 * j) * 272 + (tid & 31) * 8) = pw; } }
        __syncthreads();
        bf16x8 bfr[8];
#pragma unroll
        for (int ks = 0; ks < 8; ++ks) bfr[ks] = *(const LAS bf16x8*)(lds + 69632 + (32 * tb + r32) * 272 + (16 * ks + 8 * hi) * 2);
        const float bias = bs[g * 128 + 32 * tb + r32];
#pragma unroll
        for (int db = 0; db < 4; ++db) {
            f32x4 vg4[4];
#pragma unroll
            for (int gq = 0; gq < 4; ++gq) vg4[gq] = *(const f32x4*)(vg + 256 * g + 128 * dh + 32 * db + 8 * gq + 4 * hi);
            f32x16 acc;
#pragma unroll
            for (int i = 0; i < 16; ++i) acc[i] = 0.f;
#pragma unroll
            for (int ks = 0; ks < 8; ++ks) { const bf16x8 a = *(const LAS bf16x8*)(lds + (128 * dh + 32 * db + r32) * 272 + (16 * ks + 8 * hi) * 2); acc = MFMA32(a, bfr[ks], acc); }
#pragma unroll
            for (int gq = 0; gq < 4; ++gq) { const int d = 256 * g + 128 * dh + 32 * db + 8 * gq + 4 * hi;
                bf16_t* up = U + (size_t)t * 2048 + d; const u32x2 u2 = uu[db][gq];
                const float u0 = bf2f((unsigned short)(u2.x & 0xffffu)), u1 = bf2f((unsigned short)(u2.x >> 16)), u2f = bf2f((unsigned short)(u2.y & 0xffffu)), u3 = bf2f((unsigned short)(u2.y >> 16));
                u32x2 w; w.x = pk2(u0 * (acc[4 * gq] * vg4[gq][0] + bias), u1 * (acc[4 * gq + 1] * vg4[gq][1] + bias)); w.y = pk2(u2f * (acc[4 * gq + 2] * vg4[gq][2] + bias), u3 * (acc[4 * gq + 3] * vg4[gq][3] + bias));
                *(u32x2*)up = w; }
        }
    }
}

#define XB_TMO      128
#define XB_XCNT(j)  (256  + 64 * (j))
#define XB_XSUB(j)  (1280 + 64 * (j))
#define XB_XGEN(j)  (2304 + 64 * (j))
#define XB_TOP      3328
#define XB_TOPGEN   3392
#define XCD_BAR_WORDS 3456
#define XB_SPIN_CAP (1u << 18)
DI unsigned xb_ld(unsigned* p)              { return __hip_atomic_load(p, __ATOMIC_RELAXED, __HIP_MEMORY_SCOPE_AGENT); }
DI unsigned xb_add(unsigned* p, unsigned v) { return __hip_atomic_fetch_add(p, v, __ATOMIC_RELAXED, __HIP_MEMORY_SCOPE_AGENT); }
DI unsigned xb_xcc_id() { return (unsigned)__builtin_amdgcn_s_getreg((3 << 11) | 20) & 0xFu; }
#define XB_SPIN(cond, bar) do { unsigned _sp = 0; while (cond) { __builtin_amdgcn_s_sleep(1); \
    if ((++_sp & 255u) == 0u) { if (xb_ld(&(bar)[XB_TMO])) break; if (_sp > XB_SPIN_CAP) { atomicAdd(&(bar)[XB_TMO], 1u); break; } } } } while (0)
struct XcdBarrier { unsigned* bar; unsigned x; volatile LAS unsigned* st; };
DI XcdBarrier xcd_barrier_post(unsigned* bar, volatile LAS unsigned* st, int tid) {
    XcdBarrier b; b.bar = bar; b.x = xb_xcc_id(); b.st = st;
    if (tid == 0) (void)xb_add(&bar[XB_XCNT(b.x)], 1u);
    return b;
}
DI void xcd_barrier_complete(unsigned* bar, unsigned x, unsigned& nloc, unsigned& nx) {
    const unsigned G = gridDim.x * gridDim.y * gridDim.z;
    unsigned sum, cnt, mine, sp = 0u;
    for (;;) {
        sum = 0u; cnt = 0u; mine = 0u;
#pragma unroll
        for (unsigned j = 0; j < 16; ++j) { const unsigned c = xb_ld(&bar[XB_XCNT(j)]); sum += c; cnt += (c > 0u) ? 1u : 0u; mine = (j == x) ? c : mine; }
        if (sum == G) break;
        __builtin_amdgcn_s_sleep(1);
        if ((++sp & 255u) == 0u) { if (xb_ld(&bar[XB_TMO])) break; if (sp > XB_SPIN_CAP) { atomicAdd(&bar[XB_TMO], 1u); break; } }
    }
    nloc = mine > 0u ? mine : 1u; nx = cnt > 0u ? cnt : 1u;
}
DI void xcd_barrier(const XcdBarrier& b, int tid) {
    asm volatile("s_waitcnt vmcnt(0)" ::: "memory");
    __syncthreads();
    if (tid == 0) {
        unsigned* bar = b.bar;
        __builtin_amdgcn_s_waitcnt(0);
        unsigned nloc = b.st[0], nx = b.st[1];
        if (nloc == 0u) { xcd_barrier_complete(bar, b.x, nloc, nx); b.st[0] = nloc; b.st[1] = nx; }
        const unsigned old = xb_add(&bar[XB_XSUB(b.x)], 1u);
        const unsigned gen = old / nloc;
        if (old + 1u == (gen + 1u) * nloc) {
            __builtin_amdgcn_fence(__ATOMIC_RELEASE, "agent");
            asm volatile("s_waitcnt vmcnt(0)" ::: "memory");
            const unsigned og = xb_add(&bar[XB_TOP], 1u);
            const unsigned tg = og / nx;
            if (og + 1u == (tg + 1u) * nx) xb_add(&bar[XB_TOPGEN], 1u);
            else XB_SPIN(xb_ld(&bar[XB_TOPGEN]) == tg, bar);
            __builtin_amdgcn_fence(__ATOMIC_ACQUIRE, "agent");
            xb_add(&bar[XB_XGEN(b.x)], 1u);
            asm volatile("s_waitcnt vmcnt(0)" ::: "memory");
        } else {
            XB_SPIN(xb_ld(&bar[XB_XGEN(b.x)]) == gen, bar);
            __builtin_amdgcn_fence(__ATOMIC_ACQUIRE, "agent");
            asm volatile("s_waitcnt vmcnt(0)" ::: "memory");
        }
    }
    __syncthreads();
}

__global__ void __launch_bounds__(512, 2) mega_fwd(Params p) {
    extern __shared__ __attribute__((aligned(16))) unsigned char lds_raw[];
    LAS unsigned char* lds = (LAS unsigned char*)lds_raw;
    volatile LAS unsigned* misc = (volatile LAS unsigned*)(lds + LDS_BYTES - 64);
    const int wave_s = __builtin_amdgcn_readfirstlane((int)threadIdx.x >> 6);
    { const int t0 = wave_s * 64 + (int)__lane_id(); if (t0 < 4) misc[t0] = 0u; }
    __syncthreads();
    XcdBarrier bar = xcd_barrier_post((unsigned*)(p.ws + WS_CTL + 65536), misc, wave_s * 64 + (int)__lane_id());
    for (int ph = p.ph_lo; ph < p.ph_hi; ++ph) {
      const int nrep = (ph == p.rep_ph) ? p.rep_n : 1;
      for (int rep = 0; rep < nrep; ++rep) {
        int wv_ = wave_s; asm volatile("" : "+s"(wv_)); int lid_; asm volatile("v_mbcnt_lo_u32_b32 %0, -1, 0\n\tv_mbcnt_hi_u32_b32 %0, -1, %0" : "=&v"(lid_)); int tid = wv_ * 64 + lid_;
        int cb = blockIdx.x; asm volatile("" : "+s"(cb));
        int G = gridDim.x; asm volatile("" : "+s"(G));
        size_t wz = 0; asm volatile("" : "+s"(wz)); unsigned char* ws = p.ws + wz;
        const int lane = tid & 63, wid = __builtin_amdgcn_readfirstlane(tid >> 6);
        const int gw = cb * 8 + wid, ngw = G * 8;
        const bf16_t* XN = (const bf16_t*)(ws + WS_XN);
        const float* mod = (const float*)(ws + WS_MOD);
        float* rssb = (float*)(ws + WS_CTL + WS_RSS); const float* swb = (const float*)(ws + WS_SW);
        const bool tailmode = G >= 224;
        unsigned* tailcnt = (unsigned*)(ws + WS_CTL + 57344);
        if (ph == 0) prep_phase(p, ws, lds, tid, wid, lane, cb, G);
        else if (ph == 1) phase1(p, ws, gw, ngw, lane);
        else {
            const int l = (ph - 2) / 7, r = (ph - 2) % 7;
            if (r == 0 || r == 5) {
                const int f = (r == 5) ? 1 : 0, mi = l * 2 + f, ni = l * 3 + (f ? 2 : 0);
                const char* Wg = (const char*)(ws + WS_W + (size_t)mi * FFN_STRIDE);
                pg8::GemmDesc g0{(const char*)XN, Wg, tailmode ? 32 : 48, 22, 0, 0}, g1{(const char*)XN + (size_t)32 * 256 * D * 2, Wg, tailmode ? 16 : 0, tailmode ? 20 : 0, 32, 0};
                pg8::Sched2 S; S.init(g0, g1, D, G, cb);
                EpiGU E{(bf16_t*)(ws + WS_R + R_HID), rssb + ni * MTOK, swb + mi * 3 * 5632};
                pg8::gemm_phase<EpiGU, pg8::Sched2>(lds, tid, D, S, E);
            } else if (r == 1 || r == 6 || r == 4) {
                const char* A; const char* B; int K, jdx, nl, nj; float w;
                if (r == 4) { jdx = 1; w = 1.f; nl = l; nj = 2; if (l == 0) { A = (const char*)(ws + WS_R + R_AO); B = (const char*)(ws + WS_WO); K = 1024; } else { A = (const char*)(ws + WS_R + R_U); B = (const char*)(ws + WS_WSO); K = 2048; } }
                else { const int f = (r == 6) ? 1 : 0, mi = l * 2 + f; jdx = f ? 2 : 0; w = 0.5f; A = (const char*)(ws + WS_R + R_HID); B = (const char*)(ws + WS_W + (size_t)mi * FFN_STRIDE + FFN_DOWN); K = FH;
                       if (f == 0) { nl = l; nj = 1; } else { nl = l + 1; nj = 0; } }
                pg8::GemmDesc g0{A, B, 48, 4, 0, 0}, g1{nullptr, nullptr, 0, 0, 0, 0};
                pg8::Sched2 S; S.init(g0, g1, K, G, cb);
                const int ffn = (r == 4) ? -1 : l * 2 + ((r == 6) ? 1 : 0);
                EpiRes E{p.out, mod, p.in[8], ws, p.in[0], p.in[1], l, 3 * jdx + 2, nl < 2 ? nl * 3 + nj : -1, (tailmode && ffn >= 0) ? tailcnt + ffn * 256 : nullptr};
                pg8::gemm_phase<EpiRes, pg8::Sched2>(lds, tid, K, S, E);
                if (cb >= 192 && G > 192) {
                    int lid2; asm volatile("v_mbcnt_lo_u32_b32 %0, -1, 0\n\tv_mbcnt_hi_u32_b32 %0, -1, %0" : "=&v"(lid2)); int tid2 = wv_ * 64 + lid2;
                    if (tailmode && ffn >= 0 && cb < 224) {
                        const char* Wg = (const char*)(ws + WS_W + (size_t)ffn * FFN_STRIDE);
                        pg8::GemmDesc t0{(const char*)XN + (size_t)32 * 256 * D * 2, Wg + (size_t)20 * 256 * D * 2, 16, 2, 32, 20}, t1{nullptr, nullptr, 0, 0, 0, 0};
                        pg8::Sched2 ST; ST.init(t0, t1, D, 32, cb - 192);
                        EpiGU EG{(bf16_t*)(ws + WS_R + R_HID), rssb + (l * 3 + ((r == 6) ? 2 : 0)) * MTOK, swb + ffn * 3 * 5632};
                        pg8::gemm_phase<EpiGU, pg8::Sched2>(lds, tid2, D, ST, EG);
                        pg8::Unit tu; ST.next(0, tu);
                        asm volatile("s_waitcnt vmcnt(0)" ::: "memory"); __syncthreads();
                        asm volatile("v_mbcnt_lo_u32_b32 %0, -1, 0\n\tv_mbcnt_hi_u32_b32 %0, -1, %0" : "=&v"(lid2)); tid2 = wv_ * 64 + lid2;
                        if (tid2 == 0) { __builtin_amdgcn_fence(__ATOMIC_RELEASE, "agent"); asm volatile("s_waitcnt vmcnt(0)" ::: "memory");
                                        __hip_atomic_fetch_add(tailcnt + ffn * 256 + (tu.pm - 32) * 16, 1u, __ATOMIC_RELAXED, __HIP_MEMORY_SCOPE_AGENT); }
                        __syncthreads();
                    }
                    const int igw = (cb - 192) * 8 + wid, ingw = (G - 192) * 8;
                    if (ph == 3) { conv_caches(p, ws, (cb - 192) * 512 + tid2, (G - 192) * 512); convert_list(p, ws, lds, (1 << 1) | (1 << 5) | (1 << 9), igw, ingw, wid, lid2); }
                    else if (ph == 6) { mod_gemv(p, ws, lds, 1, 2, igw, ingw, tid2, lid2); convert_list(p, ws, lds, (1 << 2), igw, ingw, wid, lid2); sw_rows(p, ws, (1 << 1), igw, ingw, lid2); }
                    else if (ph == 8) { convert_list(p, ws, lds, (1 << 6) | (1 << 10), igw, ingw, wid, lid2); sw_rows(p, ws, (1 << 2), igw, ingw, lid2); }
                    else if (ph == 10) { convert_list(p, ws, lds, (1 << 3) | (1 << 7) | (1 << 11), igw, ingw, wid, lid2); sw_rows(p, ws, (1 << 6), igw, ingw, lid2); }
                    else if (ph == 13) sw_rows(p, ws, (1 << 3), igw, ingw, lid2);
                }
            } else if (r == 2) {
                if (l == 0) {
                    pg8::GemmDesc g0{(const char*)XN, (const char*)(ws + WS_WQK), 48, 7, 0, 0}, g1{(const char*)(ws + WS_WV), (const char*)XN, 3, 48, 0, 0};
                    pg8::Sched2 S; S.init(g0, g1, D, G, cb);
                    unsigned char* R = ws + WS_R;
                    EpiQKV E{(bf16_t*)(R + R_QNA), (bf16_t*)(R + R_VT), p.out, (const float*)(ws + WS_GTAB), rssb + 1 * MTOK, swb + SW_QKV};
                    pg8::gemm_phase<EpiQKV, pg8::Sched2>(lds, tid, D, S, E);
                } else {
                    pg8::GemmDesc g0{(const char*)XN, (const char*)(ws + WS_WSI), 48, 8, 0, 0}, g1{(const char*)(ws + WS_WSI + (size_t)2048 * D * 2), (const char*)XN, 8, 48, 0, 0};
                    pg8::Sched2 S; S.init(g0, g1, D, G, cb);
                    EpiSGU E{(bf16_t*)(ws + WS_R + R_U), (bf16_t*)(ws + WS_R + R_VTS), (float*)(ws + WS_CTL + 4096), rssb + 4 * MTOK, swb + SW_SGU};
                    pg8::gemm_phase<EpiSGU, pg8::Sched2>(lds, tid, D, S, E);
                }
            } else {
                if (l == 0) attn_phase(p, ws, lds, tid, wid, lane, rep); else spatial_phase(p, ws, lds, tid, wid, lane, cb, G);
            }
        }
        if (ph + 1 < p.ph_hi || rep + 1 < nrep) {
            { XcdBarrier b2 = bar; size_t bz = 0; asm volatile("" : "+s"(bz)); b2.bar = bar.bar + bz; xcd_barrier(b2, tid); }
        }
      }
    }
}

extern "C" void kernel_launch(void* const* d_in, const int* in_sizes, int n_in, void* d_out, int out_size, void* d_ws, size_t ws_size, hipStream_t stream) {
    static int grid = 0;
    if (grid == 0) {
        if (n_in != 27 || ws_size < WS_END) { fprintf(stderr, "kernel_launch: unexpected n_in %d / ws_size %zu\n", n_in, ws_size); grid = -1; return; }
        int dev = 0, cus = 0, per_cu = 0;
        (void)hipGetDevice(&dev);
        (void)hipDeviceGetAttribute(&cus, hipDeviceAttributeMultiprocessorCount, dev);
        if (hipFuncSetAttribute((const void*)mega_fwd, hipFuncAttributeMaxDynamicSharedMemorySize, LDS_BYTES) != hipSuccess) { fprintf(stderr, "kernel_launch: hipFuncSetAttribute failed\n"); grid = -1; return; }
        if (hipOccupancyMaxActiveBlocksPerMultiprocessor(&per_cu, (const void*)mega_fwd, 512, LDS_BYTES) != hipSuccess || per_cu < 1) { fprintf(stderr, "kernel_launch: occupancy query says %d\n", per_cu); grid = -1; (void)hipGetLastError(); return; }
        grid = cus;
    }
    if (grid < 0) return;
    (void)hipMemsetAsync((char*)d_ws + WS_CTL, 0, CTL_BYTES, stream);
    Params p{};
    for (int i = 0; i < 27; ++i) p.in[i] = (const float*)d_in[i];
    p.out = (float*)d_out; p.ws = (unsigned char*)d_ws; p.ph_lo = 0; p.ph_hi = 16; p.rep_ph = -1; p.rep_n = 1;
    void* args[] = {&p};
    hipError_t e = hipLaunchCooperativeKernel((const void*)mega_fwd, dim3(grid), dim3(512), args, LDS_BYTES, stream);
    if (e != hipSuccess) fprintf(stderr, "cooperative launch failed: %s (grid %d)\n", hipGetErrorString(e), grid);
}
```
